# Optimizing an MI355X kernel written in HIP

```python
import math
import jax, jax.numpy as jnp
from jax import lax
import numpy as np

D_MODEL = 2048
BATCH = 1
SEQ = 16384
DEPTH = 1
DEC_BATCH = 128
DEC_SEQ = 1
PAST_LEN = 16384
PAGE_SIZE = 128

D_MIX = D_MODEL
ATT_W = D_MIX // 2
HEAD_DIM = 64
N_HEADS = ATT_W // HEAD_DIM
N_KV_HEADS = 4
Q_PER_KV = N_HEADS // N_KV_HEADS
WINDOW = 128
ATT_BLOCK = WINDOW
SSM_W = D_MIX - ATT_W
SSM_HEAD_DIM = 64
N_SSM_HEADS = SSM_W // SSM_HEAD_DIM
N_SSM_GROUPS = 2
SSM_HEADS_PER_GROUP = N_SSM_HEADS // N_SSM_GROUPS
D_STATE = 128
CONV_W = 4
CONV_DIM = SSM_W + 2 * N_SSM_GROUPS * D_STATE
SSD_CHUNK = 128
D_FF = -(-8 * D_MODEL // (3 * 256)) * 256
IN_W = ATT_W + 2 * N_KV_HEADS * HEAD_DIM + SSM_W + CONV_DIM + N_SSM_HEADS
EPS = 1e-6

kernel_name = 'hybrid_swa_sink_ssd_adaln_step'


def _rmsnorm(x, g):
    xf = x.astype(jnp.float32)
    y = xf * lax.rsqrt(jnp.mean(xf * xf, axis=-1, keepdims=True) + EPS)
    return (y * g.astype(jnp.float32)).astype(x.dtype)


def _alibi_slopes():
    s = 2.0 ** (-8.0 * np.arange(1, N_HEADS + 1) / N_HEADS)
    return jnp.asarray(s.astype(np.float32)).reshape(N_KV_HEADS, Q_PER_KV)


def _sink_attend(q, k, v, dist, valid, sinks):
    f32 = jnp.float32
    s = jnp.einsum('...tkgd,...skd->...kgts', q.astype(f32), k.astype(f32)) * (HEAD_DIM ** -0.5)
    s = s - _alibi_slopes()[:, :, None, None] * dist[..., None, None, :, :].astype(f32)
    s = jnp.where(valid[..., None, None, :, :], s, -jnp.inf)
    sink = sinks.astype(f32)[:, :, None, None]
    m = jnp.maximum(jnp.max(s, axis=-1, keepdims=True), sink)
    p = jnp.exp(s - m)
    denom = jnp.sum(p, axis=-1, keepdims=True) + jnp.exp(sink - m)
    return jnp.einsum('...kgts,...skd->...tkgd', p / denom, v.astype(f32))


def _attn_prompt(q, k, v, sinks):
    b, L = q.shape[:2]
    nb = L // ATT_BLOCK
    qb = q.reshape(b, nb, ATT_BLOCK, N_KV_HEADS, Q_PER_KV, HEAD_DIM)

    def with_prev(z):
        z = z.reshape(b, nb, ATT_BLOCK, N_KV_HEADS, HEAD_DIM)
        prev = jnp.pad(z[:, :-1], ((0, 0), (1, 0), (0, 0), (0, 0), (0, 0)))
        return jnp.concatenate([prev, z], axis=2)

    a = jnp.arange(ATT_BLOCK)[:, None]
    j = jnp.arange(2 * ATT_BLOCK)[None, :]
    dist = a + ATT_BLOCK - j
    blk = jnp.arange(nb)[:, None, None]
    valid = (dist >= 0) & (dist < WINDOW) & ((blk > 0) | (j >= ATT_BLOCK))
    o = _sink_attend(qb, with_prev(k), with_prev(v), dist[None], valid, sinks)
    return o.reshape(b, L, ATT_W)


def _attn_sample(q, k, v, past_k, past_v, sinks):
    db, L = q.shape[:2]
    wb = past_k.shape[1]
    kk = jnp.concatenate([past_k.astype(k.dtype), k], axis=1)
    vv = jnp.concatenate([past_v.astype(v.dtype), v], axis=1)
    dist = jnp.arange(L)[:, None] + wb - jnp.arange(wb + L)[None, :]
    valid = (dist >= 0) & (dist < WINDOW)
    o = _sink_attend(q, kk, vv, dist, valid, sinks)
    return o.reshape(db, L, ATT_W), kk[:, L:], vv[:, L:]


def _causal_conv(xbc, prefix, w, b):
    L = xbc.shape[1]
    xp = jnp.concatenate([prefix.astype(xbc.dtype), xbc], axis=1)
    y = sum(xp[:, i:i + L] * w[i] for i in range(CONV_W)) + b
    return jax.nn.silu(y), xp[:, L:]


def _ssd(x, dt, a, bmat, cmat, h0):
    b, L = x.shape[:2]
    T = min(SSD_CHUNK, L)
    pad = -(-L // T) * T - L
    if pad:
        x = jnp.pad(x, ((0, 0), (0, pad), (0, 0), (0, 0)))
        dt = jnp.pad(dt, ((0, 0), (0, pad), (0, 0)))
        bmat = jnp.pad(bmat, ((0, 0), (0, pad), (0, 0), (0, 0)))
        cmat = jnp.pad(cmat, ((0, 0), (0, pad), (0, 0), (0, 0)))
    Lp = L + pad
    nc = Lp // T
    G, R, P, N = N_SSM_GROUPS, SSM_HEADS_PER_GROUP, SSM_HEAD_DIM, D_STATE
    X = (x * dt[..., None]).reshape(b, nc, T, G, R, P)
    acum = jnp.cumsum((dt * a).reshape(b, nc, T, G, R), axis=2)
    Bc = bmat.reshape(b, nc, T, G, N)
    Cc = cmat.reshape(b, nc, T, G, N)
    acum_t = jnp.moveaxis(acum, 2, -1)
    seg = acum_t[..., :, None] - acum_t[..., None, :]
    causal = jnp.tril(jnp.ones((T, T), dtype=bool))
    lmat = jnp.exp(jnp.where(causal, seg, -jnp.inf))
    cb = jnp.einsum('bclgn,bcsgn->bcgls', Cc, Bc)
    y_diag = jnp.einsum('bcgrls,bcsgrp->bclgrp', cb[:, :, :, None] * lmat, X)
    decay_end = jnp.exp(acum[:, :, -1:] - acum)
    chunk_states = jnp.einsum('bclgn,bclgrp->bcgrpn', Bc, X * decay_end[..., None])
    chunk_decay = jnp.exp(acum[:, :, -1])

    def step(h, inp):
        s_c, d_c = inp
        return h * d_c[..., None, None] + s_c, h

    h_final, h_prev = lax.scan(step, h0.reshape(b, G, R, P, N),
                               (jnp.moveaxis(chunk_states, 1, 0), jnp.moveaxis(chunk_decay, 1, 0)))
    h_prev = jnp.moveaxis(h_prev, 0, 1)
    y_off = jnp.einsum('bclgn,bcgrpn->bclgrp', Cc, h_prev) * jnp.exp(acum)[..., None]
    y = (y_diag + y_off).reshape(b, Lp, N_SSM_HEADS, P)[:, :L]
    return y, h_final.reshape(b, N_SSM_HEADS, P, N)


def _mixer(u, past_k, past_v, conv_prefix, h0, w_in, attn_sinks, g_attn_out, conv_w, conv_b,
           dt_bias, a_log, d_skip, g_ssm_out, w_out):
    f32 = jnp.float32
    b, L, _ = u.shape
    kv_w = N_KV_HEADS * HEAD_DIM
    cuts = [ATT_W, ATT_W + kv_w, ATT_W + 2 * kv_w, ATT_W + 2 * kv_w + SSM_W,
            ATT_W + 2 * kv_w + SSM_W + CONV_DIM]
    q, k, v, z, xbc, dt_raw = jnp.split(u @ w_in, cuts, axis=-1)
    q = q.reshape(b, L, N_KV_HEADS, Q_PER_KV, HEAD_DIM)
    k = k.reshape(b, L, N_KV_HEADS, HEAD_DIM)
    v = v.reshape(b, L, N_KV_HEADS, HEAD_DIM)
    sinks = attn_sinks.reshape(N_KV_HEADS, Q_PER_KV)
    if past_k is None:
        att = _attn_prompt(q, k, v, sinks)
        wbuf = min(WINDOW, L)
        new_k, new_v = k[:, L - wbuf:], v[:, L - wbuf:]
    else:
        att, new_k, new_v = _attn_sample(q, k, v, past_k, past_v, sinks)
    att = _rmsnorm(att.astype(u.dtype), g_attn_out)
    xbc, new_conv = _causal_conv(xbc, conv_prefix, conv_w, conv_b)
    gn = N_SSM_GROUPS * D_STATE
    xs, bm, cm = jnp.split(xbc, [SSM_W, SSM_W + gn], axis=-1)
    xs = xs.astype(f32).reshape(b, L, N_SSM_HEADS, SSM_HEAD_DIM)
    dt = jax.nn.softplus(dt_raw.astype(f32) + dt_bias.astype(f32))
    a = -jnp.exp(a_log.astype(f32))
    y, h_new = _ssd(xs, dt, a,
                    bm.astype(f32).reshape(b, L, N_SSM_GROUPS, D_STATE),
                    cm.astype(f32).reshape(b, L, N_SSM_GROUPS, D_STATE),
                    h0.astype(f32))
    y = y + d_skip.astype(f32)[:, None] * xs
    y = y.reshape(b, L, SSM_W) * jax.nn.silu(z.astype(f32))
    ssm = _rmsnorm(y, g_ssm_out).astype(u.dtype)
    out = jnp.concatenate([att, ssm], axis=-1) @ w_out
    return out, new_k, new_v, new_conv, h_new


def _layer(x, c, past_k, past_v, conv_prefix, h0, w_ada, b_ada, g_pre_mix, g_post_mix, w_in,
           attn_sinks, g_attn_out, conv_w, conv_b, dt_bias, a_log, d_skip, g_ssm_out, w_out,
           g_pre_ffn, g_post_ffn, w_gate, w_up, w_down):
    mod = (jax.nn.silu(c) @ w_ada + b_ada)[:, None, :]
    sh1, sc1, gt1, sh2, sc2, gt2 = jnp.split(mod, 6, axis=-1)
    u = _rmsnorm(x, g_pre_mix) * (1 + sc1) + sh1
    mix, nk, nv, nconv, nh = _mixer(u, past_k, past_v, conv_prefix, h0, w_in, attn_sinks,
                                    g_attn_out, conv_w, conv_b, dt_bias, a_log, d_skip,
                                    g_ssm_out, w_out)
    x = x + gt1 * _rmsnorm(mix, g_post_mix)
    u = _rmsnorm(x, g_pre_ffn) * (1 + sc2) + sh2
    f = (jax.nn.silu(u @ w_gate) * (u @ w_up)) @ w_down
    x = x + gt2 * _rmsnorm(f, g_post_ffn)
    return x, nk, nv, nconv, nh


def setup_inputs(seed: int = 0) -> dict:
    key = jax.random.key(seed)
    ks = iter(jax.random.split(key, 40))
    f32 = jnp.float32

    def nrm(shape, scale):
        return jax.random.normal(next(ks), shape, f32) * scale

    def gain(shape):
        return 1.0 + nrm(shape, 0.02)

    wbuf = min(WINDOW, PAST_LEN)
    dt0 = jnp.exp(jax.random.uniform(next(ks), (DEPTH, N_SSM_HEADS), f32,
                                     math.log(1e-3), math.log(1e-1)))
    return {
        'x_prompt': nrm((BATCH, SEQ, D_MODEL), 1.0),
        'x_sample': nrm((DEC_BATCH, DEC_SEQ, D_MODEL), 1.0),
        'cache_k': nrm((DEPTH, DEC_BATCH, wbuf, N_KV_HEADS, HEAD_DIM), 1.0),
        'cache_v': nrm((DEPTH, DEC_BATCH, wbuf, N_KV_HEADS, HEAD_DIM), 1.0),
        'state_conv': nrm((DEPTH, DEC_BATCH, CONV_W - 1, CONV_DIM), 1.0),
        'state_ssm': nrm((DEPTH, DEC_BATCH, N_SSM_HEADS, SSM_HEAD_DIM, D_STATE), 0.5),
        'c_prompt': nrm((BATCH, D_MODEL), 1.0),
        'c_sample': nrm((DEC_BATCH, D_MODEL), 1.0),
        'w_ada': nrm((DEPTH, D_MODEL, 6 * D_MODEL), 0.5 * D_MODEL ** -0.5),
        'b_ada': nrm((DEPTH, 6 * D_MODEL), 0.01),
        'g_pre_mix': gain((DEPTH, D_MODEL)),
        'g_post_mix': gain((DEPTH, D_MODEL)),
        'w_in': nrm((DEPTH, D_MODEL, IN_W), D_MODEL ** -0.5),
        'attn_sinks': nrm((DEPTH, N_HEADS), 1.0),
        'g_attn_out': gain((DEPTH, ATT_W)),
        'conv_w': nrm((DEPTH, CONV_W, CONV_DIM), CONV_W ** -0.5),
        'conv_b': nrm((DEPTH, CONV_DIM), 0.02),
        'dt_bias': dt0 + jnp.log(-jnp.expm1(-dt0)),
        'a_log': jnp.log(jax.random.uniform(next(ks), (DEPTH, N_SSM_HEADS), f32, 1.0, 16.0)),
        'd_skip': 1.0 + nrm((DEPTH, N_SSM_HEADS), 0.1),
        'g_ssm_out': gain((DEPTH, SSM_W)),
        'w_out': nrm((DEPTH, D_MIX, D_MODEL), D_MIX ** -0.5),
        'g_pre_ffn': gain((DEPTH, D_MODEL)),
        'g_post_ffn': gain((DEPTH, D_MODEL)),
        'w_gate': nrm((DEPTH, D_MODEL, D_FF), D_MODEL ** -0.5),
        'w_up': nrm((DEPTH, D_MODEL, D_FF), D_MODEL ** -0.5),
        'w_down': nrm((DEPTH, D_FF, D_MODEL), D_FF ** -0.5),
    }


def reference(x_prompt, x_sample, cache_k, cache_v, state_conv, state_ssm, c_prompt, c_sample,
              w_ada, b_ada, g_pre_mix, g_post_mix, w_in, attn_sinks, g_attn_out, conv_w, conv_b,
              dt_bias, a_log, d_skip, g_ssm_out, w_out, g_pre_ffn, g_post_ffn, w_gate, w_up, w_down):
    weights = (w_ada, b_ada, g_pre_mix, g_post_mix, w_in, attn_sinks, g_attn_out, conv_w, conv_b,
               dt_bias, a_log, d_skip, g_ssm_out, w_out, g_pre_ffn, g_post_ffn, w_gate, w_up, w_down)
    yp, ys = x_prompt, x_sample
    bp = x_prompt.shape[0]
    kp_l, vp_l, cp_l, hp_l, ks_l, vs_l, cs_l, hs_l = [], [], [], [], [], [], [], []
    for l in range(DEPTH):
        lw = [w[l] for w in weights]
        conv0 = jnp.zeros((bp, CONV_W - 1, CONV_DIM), yp.dtype)
        h0 = jnp.zeros((bp, N_SSM_HEADS, SSM_HEAD_DIM, D_STATE), jnp.float32)
        yp, kp, vp, cp, hp = _layer(yp, c_prompt, None, None, conv0, h0, *lw)
        ys, ksm, vsm, csm, hsm = _layer(ys, c_sample, cache_k[l], cache_v[l], state_conv[l],
                                        state_ssm[l], *lw)
        kp_l.append(kp); vp_l.append(vp); cp_l.append(cp); hp_l.append(hp)
        ks_l.append(ksm); vs_l.append(vsm); cs_l.append(csm); hs_l.append(hsm)
    k_prompt = jnp.stack(kp_l).astype(cache_k.dtype)
    v_prompt = jnp.stack(vp_l).astype(cache_v.dtype)
    conv_prompt = jnp.stack(cp_l).astype(state_conv.dtype)
    ssm_prompt = jnp.stack(hp_l).astype(state_ssm.dtype)
    k_sample = jnp.stack(ks_l).astype(cache_k.dtype)
    v_sample = jnp.stack(vs_l).astype(cache_v.dtype)
    conv_sample = jnp.stack(cs_l).astype(state_conv.dtype)
    ssm_sample = jnp.stack(hs_l).astype(state_ssm.dtype)
    return (yp, ys, k_prompt, v_prompt, conv_prompt, ssm_prompt,
            k_sample, v_sample, conv_sample, ssm_sample)
```

```cpp
#include <hip/hip_runtime.h>
#include <cstdio>
#include <cstdint>

#ifndef MK_N_LAUNCHES
#define MK_N_LAUNCHES 1
#endif

#ifndef PROBE_MASK
#define PROBE_MASK 0u
#endif
#ifndef PROBE_SUB
#define PROBE_SUB 0u
#endif
#define LAS __attribute__((address_space(3)))
#define GAS __attribute__((address_space(1)))
typedef unsigned short bf16;
typedef short bf16x8 __attribute__((ext_vector_type(8)));
typedef float f32x2 __attribute__((ext_vector_type(2)));
typedef float f32x4 __attribute__((ext_vector_type(4)));
typedef float f32x16 __attribute__((ext_vector_type(16)));
typedef unsigned u32x2 __attribute__((ext_vector_type(2)));
typedef unsigned u32x4 __attribute__((ext_vector_type(4)));
typedef __bf16 bf16x2_t __attribute__((ext_vector_type(2)));
typedef int i32x4 __attribute__((ext_vector_type(4)));

constexpr int DM = 2048;
constexpr int LP = 16384;
constexpr int NB = 128;
constexpr int MT = LP + NB;
constexpr int MP = 16640;
constexpr int INW = 4112;
constexpr int NPROJ = 4096;
constexpr int DFF = 5632;
constexpr int CONVD = 1536;
constexpr float EPS = 1e-6f;
constexpr float LOG2E = 1.4426950408889634f;
constexpr int C_Q = 0, C_K = 1024, C_V = 1280, C_Z = 1536, C_X = 2560, C_B = 3584, C_C = 3840;
constexpr size_t PSLAB = (size_t)16384 * 64;
constexpr size_t PBC0 = (size_t)3584 * 16384;
__host__ __device__ __forceinline__ size_t proj_q(int head) { return (size_t)head * PSLAB; }
__host__ __device__ __forceinline__ size_t proj_k(int kvh) { return (size_t)(16 + kvh) * PSLAB; }
__host__ __device__ __forceinline__ size_t proj_v(int kvh) { return (size_t)(20 + kvh) * PSLAB; }
__host__ __device__ __forceinline__ size_t proj_z(int h) { return (size_t)(24 + h) * PSLAB; }
__host__ __device__ __forceinline__ size_t proj_x(int h) { return (size_t)(40 + h) * PSLAB; }
__host__ __device__ __forceinline__ size_t proj_b(int g) { return PBC0 + (size_t)g * 2 * PSLAB; }
__host__ __device__ __forceinline__ size_t proj_c(int g) { return PBC0 + (size_t)(2 + g) * 2 * PSLAB; }
constexpr size_t O_Y = 0, O_KP = 33816576, O_VP = 33849344, O_CP = 33882112, O_HP = 33886720, O_KS = 34017792, O_VS = 38212096, O_CS = 42406400, O_HS = 42996224;

constexpr size_t MiB = 1u << 20;
constexpr size_t WS_CTL = 0, CTL_ZERO_BYTES = 1 * MiB;
constexpr size_t WS_DT = 1 * MiB;
constexpr size_t WS_SSQA = WS_DT + (size_t)MT * 16 * 4;
constexpr size_t WS_SSQS = WS_SSQA + (size_t)MT * 16 * 4;
constexpr size_t WS_SSQ2 = WS_SSQS + (size_t)MT * 16 * 4;
constexpr size_t WS_SSQ2S = WS_SSQ2 + (size_t)LP * 32 * 4;
constexpr size_t WS_SSQ4 = WS_SSQ2S + 65536;
constexpr size_t WS_SSQ4S = WS_SSQ4 + (size_t)LP * 32 * 4;
constexpr size_t WS_DECAY = WS_SSQ4S + 65536;
constexpr size_t WS_WDT = WS_DECAY + 8192;
static_assert(WS_WDT + 131072 <= 8 * MiB + 524288, "small arrays");
constexpr size_t WS_MODF = 8 * MiB + 524288;
constexpr size_t WS_TAIL = 12 * MiB + 786432;
static_assert(WS_MODF + (size_t)129 * 8192 * 4 <= WS_TAIL && WS_TAIL + (size_t)256 * 4096 * 4 <= 17 * MiB, "ws head");
constexpr size_t WS_MODP = 17 * MiB;
constexpr size_t WS_WIN = 66 * MiB;
constexpr size_t WS_WOUT = 82 * MiB;
constexpr size_t WS_WGU = 90 * MiB;
constexpr size_t WS_WD = 134 * MiB;
constexpr size_t WS_U = 156 * MiB;
constexpr size_t WS_F = 333 * MiB;
constexpr size_t WS_U8 = 156 * MiB;
constexpr size_t WS_WGU8 = 189 * MiB;
constexpr size_t WS_ASC = 512 * 1024;
constexpr size_t WS_WSC = 640 * 1024;
constexpr size_t WS_ASC1 = 896 * 1024;
constexpr size_t WS_WSC1 = 976 * 1024;
constexpr size_t WS_U18 = 351 * MiB;
constexpr size_t WS_WIN8 = 416 * MiB;
constexpr size_t WS_HSC = 704 * 1024;
constexpr size_t WS_WSCD = 832 * 1024;
constexpr size_t WS_WD8 = 66 * MiB;
constexpr size_t WS_H8 = 90 * MiB;
static_assert(WS_H8 + (size_t)MT * DFF <= 189 * MiB && WS_WD8 + (size_t)DM * DFF <= 90 * MiB, "int8 overlays");
constexpr size_t WS_PROJ = 221 * MiB;
constexpr size_t WS_X1 = 221 * MiB;
constexpr size_t WS_MIXOUT = 286 * MiB;
constexpr size_t WS_H = 333 * MiB;
constexpr size_t WS_MIX = 351 * MiB;
constexpr size_t WS_STATES = 416 * MiB;
constexpr size_t WS_HPREV = 480 * MiB;
constexpr size_t WS_END = 512 * MiB;
static_assert(WS_H + (size_t)MT * DFF * 2 <= WS_END && WS_MIXOUT + (size_t)MT * DM * 2 <= WS_MIX && WS_X1 + (size_t)MT * DM * 2 <= WS_MIXOUT && WS_PROJ + (size_t)MT * NPROJ * 2 <= WS_MIX && WS_MODP + (size_t)8 * 129 * 12288 * 4 <= WS_WIN, "ws map");
constexpr int CW_BAR = 4096;

constexpr int RING_BYTES = 131072;
constexpr int TBL_OFF = RING_BYTES;
constexpr int P1PRM_OFF = RING_BYTES;
constexpr int LDSCTL_OFF = RING_BYTES + 16384, MISC_OFF = LDSCTL_OFF + 320;
constexpr int LDS_BYTES = 147456 + 512;

#define LDS_WAIT() asm volatile("s_waitcnt lgkmcnt(0)" ::: "memory")
#define VM_WAIT() asm volatile("s_waitcnt vmcnt(0)" ::: "memory")
__device__ __forceinline__ unsigned cvtpk(float lo, float hi) { f32x2 v = {lo, hi}; bf16x2_t b = __builtin_convertvector(v, bf16x2_t); return __builtin_bit_cast(unsigned, b); }
__device__ __forceinline__ unsigned pack_i8(float a, float b, float c, float d) {
    const int ia = (int)__builtin_rintf(fminf(fmaxf(a, -127.f), 127.f)), ib = (int)__builtin_rintf(fminf(fmaxf(b, -127.f), 127.f));
    const int ic = (int)__builtin_rintf(fminf(fmaxf(c, -127.f), 127.f)), id = (int)__builtin_rintf(fminf(fmaxf(d, -127.f), 127.f));
    return (unsigned)(ia & 255) | ((unsigned)(ib & 255) << 8) | ((unsigned)(ic & 255) << 16) | ((unsigned)(id & 255) << 24);
}
__device__ __forceinline__ float bflo(unsigned u) { return __uint_as_float(u << 16); }
__device__ __forceinline__ float bfhi(unsigned u) { return __uint_as_float(u & 0xffff0000u); }
__device__ __forceinline__ float silu_f(float x) { return x * __builtin_amdgcn_rcpf(1.f + __expf(-x)); }
__device__ __forceinline__ float wave_sum(float v) {
#pragma unroll
    for (int o = 1; o < 64; o <<= 1) v += __shfl_xor(v, o);
    return v;
}
__device__ __forceinline__ float wave_max(float v) {
#pragma unroll
    for (int o = 1; o < 64; o <<= 1) v = fmaxf(v, __shfl_xor(v, o));
    return v;
}

namespace pg8 {
typedef unsigned short bf16_t;
constexpr int BM = 256, BK = 64, HALF = 128, HTB = HALF * BK * 2, STAGE_BYTES = 8 * HTB, NXCD = 8, WGM = 8;
__host__ __device__ __forceinline__ int lds_byte(int r, int c) { const int st = (r >> 4) * 2 + (c >> 5), rr = r & 15, cc = c & 31, ob = rr * 64 + cc * 2; return st * 1024 + (ob ^ (((ob >> 9) & 1) << 5)); }
__host__ __device__ __forceinline__ void stage_rc(int b, int& R, int& C) { const int st = b / 1024, sb = b % 1024, swz = sb ^ (((sb >> 9) & 1) << 5); R = (st >> 1) * 16 + swz / 64; C = (st & 1) * 32 + (swz % 64) / 2; }
__host__ __device__ __forceinline__ int perm32(int rho) { const int n = rho >> 4, i = rho & 15; return 8 * (i >> 2) + 4 * n + (i & 3); }
struct Unit { int pm, pn; };
struct Gemm { const bf16_t* A; const bf16_t* Bt; int M, N, K; unsigned long long nmap; };
struct StaticOrder {
    int nM, nN, nwg, G, c, wgm;
    __host__ __device__ void init(int M, int N, int G_, int c_, int wgm_ = WGM) { nM = M / BM; nN = N / BM; nwg = nM * nN; G = G_; c = c_; wgm = wgm_; }
    __host__ __device__ bool next(int i, Unit& u) const {
        const long L = (long)i * G + c; if (L >= nwg) return false;
        int wgid = (int)L; { const int q = nwg / NXCD, r = nwg % NXCD, xcd = wgid % NXCD, off = wgid / NXCD; wgid = (xcd < r ? xcd * (q + 1) : r * (q + 1) + (xcd - r) * q) + off; }
        const int nig = wgm * nN, gid = wgid / nig, fm = gid * wgm, gsz = (nM - fm) < wgm ? (nM - fm) : wgm;
        u.pm = fm + ((wgid % nig) % gsz); u.pn = (wgid % nig) / gsz; return true;
    }
};


template <bool I8_>
struct EpiProj {
    static constexpr bool MID = false;
    bf16_t* O; int ldc; float* tail; const float* asc; const float* wsc;
    __device__ __forceinline__ void begin(const Unit&, int, LAS unsigned char*) const {}
    __device__ __forceinline__ void mid(f32x4 (&)[2][2][4][2], int, int, int, LAS unsigned char*) const {}
    __device__ __forceinline__ void operator()(const f32x4 (&acc)[2][2][4][2], const Unit& u, int, int wr, int wc, int fr, int fq, LAS unsigned char*) const {
        const int row0 = u.pm * BM + wr * 64 + fr, col0 = u.pn * BM + wc * 32 + 8 * fq;
#pragma unroll
        for (int ai = 0; ai < 2; ++ai)
#pragma unroll
            for (int m = 0; m < 4; ++m) {
                const int row = row0 + ai * HALF + m * 16;
#pragma unroll
                for (int bj = 0; bj < 2; ++bj) {
                    const int col = col0 + bj * HALF;
                    f32x4 v0, v1;
                    if (I8_) { const float sa = asc[row]; const f32x4 w0 = *(const f32x4*)(wsc + col), w1 = *(const f32x4*)(wsc + col + 4);
                      const i32x4 i0 = __builtin_bit_cast(i32x4, acc[ai][bj][m][0]), i1 = __builtin_bit_cast(i32x4, acc[ai][bj][m][1]);
#pragma unroll
                      for (int j = 0; j < 4; ++j) { v0[j] = (float)i0[j] * (sa * w0[j]); v1[j] = (float)i1[j] * (sa * w1[j]); } }
                    else { v0 = acc[ai][bj][m][0]; v1 = acc[ai][bj][m][1]; }
                    u32x4 w; w.x = cvtpk(v0[0], v0[1]); w.y = cvtpk(v0[2], v0[3]); w.z = cvtpk(v1[0], v1[1]); w.w = cvtpk(v1[2], v1[3]);
                    bf16_t* dst = (col < 3584) ? O + (size_t)(col >> 6) * PSLAB + (size_t)row * 64 + (col & 63)
                                               : O + PBC0 + (size_t)((col - 3584) >> 7) * 2 * PSLAB + (size_t)row * 128 + (col & 127);
                    *(u32x4*)dst = w;
                    if (u.pm == 63 && ai == 1) { float* tp = tail + (size_t)(row - (LP - 128)) * NPROJ + col0 + bj * HALF; *(f32x4*)tp = v0; *(f32x4*)(tp + 4) = v1; }
                }
            }
    }
};
struct EpiSwiGLU {
    static constexpr bool MID = false;
    bf16_t* O; int ldc; const float* asc; const float* wsc;
    __device__ __forceinline__ void begin(const Unit&, int, LAS unsigned char*) const {}
    __device__ __forceinline__ void mid(f32x4 (&)[2][2][4][2], int, int, int, LAS unsigned char*) const {}
    __device__ __forceinline__ void operator()(const f32x4 (&acc)[2][2][4][2], const Unit& u, int, int wr, int wc, int fr, int fq, LAS unsigned char*) const {
        const int row0 = u.pm * BM + wr * 64 + fr, col0 = u.pn * HALF + wc * 32 + 8 * fq;
#pragma unroll
        for (int ai = 0; ai < 2; ++ai)
#pragma unroll
            for (int m = 0; m < 4; ++m) {
                bf16_t* rowp = O + (size_t)(row0 + ai * HALF + m * 16) * ldc + col0;
                const float sa = asc[row0 + ai * HALF + m * 16];
                float h[8];
#pragma unroll
                for (int n = 0; n < 2; ++n) {
                    const int wr0 = u.pn * BM + wc * 32 + 8 * fq + 4 * n;
                    const f32x4 sg = *(const f32x4*)(wsc + wr0), su = *(const f32x4*)(wsc + wr0 + HALF);
                    const i32x4 gi = __builtin_bit_cast(i32x4, acc[ai][0][m][n]), ui = __builtin_bit_cast(i32x4, acc[ai][1][m][n]);
#pragma unroll
                    for (int j = 0; j < 4; ++j) { const float g = (float)gi[j] * (sa * sg[j]), up = (float)ui[j] * (sa * su[j]); h[n * 4 + j] = silu_f(g) * up; }
                }
                u32x4 w; w.x = cvtpk(h[0], h[1]); w.y = cvtpk(h[2], h[3]); w.z = cvtpk(h[4], h[5]); w.w = cvtpk(h[6], h[7]);
                *(u32x4*)rowp = w;
            }
    }
};
template <bool MID_, bool I8_ = false>
struct EpiRowSsq {
    static constexpr bool MID = MID_;
    bf16_t* O; int ldc; float* ssq; const float* ssqa; const float* ssqs; const float* asc; const float* wsc;
    __device__ __forceinline__ void begin(const Unit& u, int ui, LAS unsigned char* lds) const {
        if (MID_) {
            const int tid = threadIdx.x;
            if (tid < 256) {
                const int row = u.pm * BM + tid;
                const f32x4* pa = (const f32x4*)(ssqa + (size_t)row * 16); const f32x4* ps = (const f32x4*)(ssqs + (size_t)row * 16);
                float sa = 0.f, ss = 0.f;
#pragma unroll
                for (int i = 0; i < 4; ++i) { const f32x4 a = pa[i], s = ps[i]; sa += (a[0] + a[1]) + (a[2] + a[3]); ss += (s[0] + s[1]) + (s[2] + s[3]); }
                const float ra = 1.0f / sqrtf(sa * (1.0f / 1024.0f) + EPS), rs = 1.0f / sqrtf(ss * (1.0f / 1024.0f) + EPS);
                LAS f32x2* T = (LAS f32x2*)(lds + TBL_OFF) + (ui & 1) * 256;
                T[tid] = (f32x2){ra / rs, rs};
            }
        }
    }
    __device__ __forceinline__ void mid(f32x4 (&acc)[2][2][4][2], int ui, int wr, int fr, LAS unsigned char* lds) const {
        if (MID_) {
            const LAS f32x2* T = (const LAS f32x2*)(lds + TBL_OFF) + (ui & 1) * 256;
#pragma unroll
            for (int ai = 0; ai < 2; ++ai)
#pragma unroll
                for (int m = 0; m < 4; ++m) { const float r = T[ai * HALF + wr * 64 + m * 16 + fr].x;
#pragma unroll
                    for (int bj = 0; bj < 2; ++bj)
#pragma unroll
                        for (int n = 0; n < 2; ++n) acc[ai][bj][m][n] = acc[ai][bj][m][n] * r; }
        }
    }
    __device__ __forceinline__ void operator()(const f32x4 (&acc)[2][2][4][2], const Unit& u, int ui, int wr, int wc, int fr, int fq, LAS unsigned char* lds) const {
        const LAS f32x2* T = (const LAS f32x2*)(lds + TBL_OFF) + (ui & 1) * 256;
        const int col0 = u.pn * BM + wc * 32 + 8 * fq;
#pragma unroll
        for (int ai = 0; ai < 2; ++ai)
#pragma unroll
            for (int m = 0; m < 4; ++m) {
                const int rt = ai * HALF + wr * 64 + m * 16 + fr, row = u.pm * BM + rt;
                float sc = 1.f; if (MID_) sc = T[rt].y;
                bf16_t* rowp = O + (size_t)row * ldc + col0; float q = 0.f;
#pragma unroll
                for (int bj = 0; bj < 2; ++bj) {
                    f32x4 v0, v1;
                    if (I8_) { const float sa = asc[row]; const f32x4 w0 = *(const f32x4*)(wsc + col0 + bj * HALF), w1 = *(const f32x4*)(wsc + col0 + bj * HALF + 4);
                        const i32x4 i0 = __builtin_bit_cast(i32x4, acc[ai][bj][m][0]), i1 = __builtin_bit_cast(i32x4, acc[ai][bj][m][1]);
#pragma unroll
                        for (int j = 0; j < 4; ++j) { v0[j] = (float)i0[j] * (sa * w0[j]); v1[j] = (float)i1[j] * (sa * w1[j]); } }
                    else { v0 = acc[ai][bj][m][0] * sc; v1 = acc[ai][bj][m][1] * sc; }
                    q += (v0[0] * v0[0] + v0[1] * v0[1]) + (v0[2] * v0[2] + v0[3] * v0[3]) + (v1[0] * v1[0] + v1[1] * v1[1]) + (v1[2] * v1[2] + v1[3] * v1[3]);
                    u32x4 w; w.x = cvtpk(v0[0], v0[1]); w.y = cvtpk(v0[2], v0[3]); w.z = cvtpk(v1[0], v1[1]); w.w = cvtpk(v1[2], v1[3]);
                    *(u32x4*)(rowp + bj * HALF) = w;
                }
                q += __shfl_xor(q, 16); q += __shfl_xor(q, 32);
                if (fq == 0) ssq[(size_t)row * 32 + u.pn * 4 + wc] = q;
            }
    }
};

template <class Epi, bool ALIGN_EPI = true, bool I8 = false>
__device__ __forceinline__ void gemm_phase(LAS unsigned char* lds, const Gemm g, const StaticOrder& S, const Epi& E) {
    const int tid = threadIdx.x, wid = __builtin_amdgcn_readfirstlane(tid >> 6), lane = tid & 63, wr = wid >> 2, wc = wid & 3, fr = lane & 15, fq = lane >> 4;
    const int K = g.K, nt = K / BK;
    unsigned voffA[2], voffB[2];
#pragma unroll
    for (int i = 0; i < 2; ++i) { int R, C; stage_rc(tid * 16 + i * 8192, R, C); const int Rb = (R & ~31) + perm32(R & 31);
        voffA[i] = (unsigned)(R * K + C) * 2u; voffB[i] = (unsigned)(Rb * K + C) * 2u; }
    const size_t kstep = (size_t)(BK * 2);
    const size_t hstep = (size_t)HALF * K * 2;
    const size_t tstep = 2 * hstep;
    const unsigned ldsw = (unsigned)wid * 1024u;
    const int aoff = lds_byte(wr * 64 + fr, fq * 8), boff = lds_byte(wc * 32 + fr, fq * 8);
#define PG8_SA(b, h) (((b) * 2 + (h)) * HTB)
#define PG8_SB(b, h) ((4 + (b) * 2 + (h)) * HTB)
#define PG8_STAGE(bufoff, gbase, voff) do { _Pragma("unroll") for (int _i = 0; _i < 2; ++_i) \
        __builtin_amdgcn_global_load_lds((const unsigned*)((const char*)(gbase) + (voff)[_i]), (LAS unsigned*)(lds + (bufoff) + ldsw + _i * 8192), 16, 0, 0); } while (0)
#define PG8_LDA(dst, b, h) do { _Pragma("unroll") for (int m = 0; m < 4; ++m) _Pragma("unroll") for (int k = 0; k < 2; ++k) dst[m][k] = *(const LAS bf16x8*)(lds + PG8_SA(b, h) + aoff + m * 2048 + k * 1024); } while (0)
#define PG8_LDB(dst, b, h) do { _Pragma("unroll") for (int n = 0; n < 2; ++n) _Pragma("unroll") for (int k = 0; k < 2; ++k) dst[n][k] = *(const LAS bf16x8*)(lds + PG8_SB(b, h) + boff + n * 2048 + k * 1024); } while (0)
#define PG8_MMA(ai, bj, At, Bt) do { __builtin_amdgcn_s_setprio(1); _Pragma("unroll") for (int m = 0; m < 4; ++m) _Pragma("unroll") for (int n = 0; n < 2; ++n) _Pragma("unroll") for (int k = 0; k < 2; ++k) \
        { if constexpr (I8) acc[ai][bj][m][n] = __builtin_bit_cast(f32x4, __builtin_amdgcn_mfma_i32_16x16x64_i8(__builtin_bit_cast(i32x4, Bt[n][k]), __builtin_bit_cast(i32x4, At[m][k]), __builtin_bit_cast(i32x4, acc[ai][bj][m][n]), 0, 0, 0)); \
          else acc[ai][bj][m][n] = __builtin_amdgcn_mfma_f32_16x16x32_bf16(Bt[n][k], At[m][k], acc[ai][bj][m][n], 0, 0, 0); } __builtin_amdgcn_s_setprio(0); } while (0)
#define PG8_WAIT_V(n) asm volatile("s_waitcnt vmcnt(" #n ")" ::: "memory")
#define PG8_WAIT_L(n) asm volatile("s_waitcnt lgkmcnt(" #n ")" ::: "memory")
#define PG8_BAR __builtin_amdgcn_s_barrier()
#define PG8_SCHED __builtin_amdgcn_sched_barrier(0)
    Unit cur, nxt; int ui = 0;
    if (!S.next(0, cur)) return;
    f32x4 acc[2][2][4][2];
#pragma unroll
    for (int a = 0; a < 2; ++a)
#pragma unroll
        for (int b = 0; b < 2; ++b)
#pragma unroll
            for (int m = 0; m < 4; ++m)
#pragma unroll
                for (int n = 0; n < 2; ++n) acc[a][b][m][n] = (f32x4){0.f, 0.f, 0.f, 0.f};
    bf16x8 At[4][2], B0[2][2], B1[2][2];
    const unsigned long long nmap = g.nmap;
#define PG8_PN(u_) (nmap ? (int)((nmap >> (4 * (u_).pn)) & 15ull) : (u_).pn)
    cur.pn = PG8_PN(cur);
    const char* cA = (const char*)g.A + (size_t)cur.pm * tstep; const char* cB = (const char*)g.Bt + (size_t)cur.pn * tstep;
    E.begin(cur, 0, lds);
    PG8_STAGE(PG8_SB(0, 0), cB, voffB); PG8_STAGE(PG8_SB(0, 1), cB + hstep, voffB); PG8_STAGE(PG8_SA(0, 0), cA, voffA); PG8_STAGE(PG8_SA(0, 1), cA + hstep, voffA);
    if (wr == 1) PG8_BAR;
    PG8_WAIT_V(2); PG8_BAR;
    PG8_STAGE(PG8_SB(1, 0), cB + kstep, voffB); PG8_STAGE(PG8_SA(1, 0), cA + kstep, voffA); PG8_STAGE(PG8_SB(1, 1), cB + hstep + kstep, voffB);
    PG8_WAIT_V(6); PG8_BAR;
    for (;;) {
        const bool has_next = S.next(ui + 1, nxt); if (has_next) nxt.pn = PG8_PN(nxt);
        const char* nA = has_next ? (const char*)g.A + (size_t)nxt.pm * tstep : cA; const char* nB = has_next ? (const char*)g.Bt + (size_t)nxt.pn * tstep : cB;
        for (int t = 0; t < nt; t += 2) {
            const bool last = (t == nt - 2);
            const char* a1 = cA + (size_t)(t + 1) * kstep;
            const char* a2 = last ? nA : cA + (size_t)(t + 2) * kstep; const char* b2 = last ? nB : cB + (size_t)(t + 2) * kstep;
            const char* a3 = a2 + kstep; const char* b3 = b2 + kstep;
            if constexpr (Epi::MID) { if (t == (nt >> 1)) E.mid(acc, ui, wr, fr, lds); }
            PG8_LDB(B0, 0, 0); PG8_LDB(B1, 0, 1); PG8_SCHED; PG8_LDA(At, 0, 0); PG8_STAGE(PG8_SA(1, 1), a1 + hstep, voffA);
            PG8_WAIT_V(8); PG8_WAIT_L(0); PG8_BAR; PG8_MMA(0, 0, At, B0); PG8_MMA(0, 1, At, B1); PG8_BAR; PG8_SCHED;
            PG8_LDA(At, 0, 1); PG8_STAGE(PG8_SB(0, 0), b2, voffB); PG8_STAGE(PG8_SB(0, 1), b2 + hstep, voffB); PG8_STAGE(PG8_SA(0, 0), a2, voffA);
            PG8_WAIT_V(8); PG8_WAIT_L(0); PG8_BAR; PG8_MMA(1, 0, At, B0); PG8_MMA(1, 1, At, B1); PG8_BAR; PG8_SCHED;
            PG8_LDB(B0, 1, 0); PG8_LDB(B1, 1, 1); PG8_SCHED; PG8_LDA(At, 1, 0); PG8_STAGE(PG8_SA(0, 1), a2 + hstep, voffA);
            PG8_WAIT_V(8); PG8_WAIT_L(0); PG8_BAR; PG8_MMA(0, 0, At, B0); PG8_MMA(0, 1, At, B1); PG8_BAR; PG8_SCHED;
            PG8_LDA(At, 1, 1); PG8_STAGE(PG8_SB(1, 0), b3, voffB); PG8_STAGE(PG8_SB(1, 1), b3 + hstep, voffB); PG8_STAGE(PG8_SA(1, 0), a3, voffA);
            PG8_WAIT_V(8); PG8_WAIT_L(0); PG8_BAR; PG8_MMA(1, 0, At, B0); PG8_MMA(1, 1, At, B1); PG8_BAR; PG8_SCHED;
        }
        if constexpr (ALIGN_EPI) { if (wr == 0) PG8_BAR; }
        E(acc, cur, ui, wr, wc, fr, fq, lds);
        if (!has_next) break;
#pragma unroll
        for (int a = 0; a < 2; ++a)
#pragma unroll
            for (int b = 0; b < 2; ++b)
#pragma unroll
                for (int m = 0; m < 4; ++m)
#pragma unroll
                    for (int n = 0; n < 2; ++n) acc[a][b][m][n] = (f32x4){0.f, 0.f, 0.f, 0.f};
        cur = nxt; cA = nA; cB = nB; ++ui;
        E.begin(cur, ui, lds);
        if constexpr (ALIGN_EPI) { if (wr == 1) PG8_BAR; }
    }
    PG8_WAIT_V(0);
    if constexpr (!ALIGN_EPI) { if (wr == 0) PG8_BAR; }
    PG8_BAR;
#undef PG8_PN
#undef PG8_SA
#undef PG8_SB
#undef PG8_STAGE
#undef PG8_LDA
#undef PG8_LDB
#undef PG8_MMA
#undef PG8_WAIT_V
#undef PG8_WAIT_L
#undef PG8_BAR
#undef PG8_SCHED
}
}

#define RLX_AGENT __ATOMIC_RELAXED, __HIP_MEMORY_SCOPE_AGENT
#define XB_TMO      128
#define XB_XCNT(j)  (256  + 64 * (j))
#define XB_XSUB(j)  (1280 + 64 * (j))
#define XB_XGEN(j)  (2304 + 64 * (j))
#define XB_TOP      3328
#define XB_TOPGEN   3392
#define XCD_BAR_WORDS 3456
#define XB_SPIN_CAP (1u << 22)
__device__ __forceinline__ unsigned xb_ld(unsigned* p)              { return __hip_atomic_load(p, __ATOMIC_RELAXED, __HIP_MEMORY_SCOPE_AGENT); }
__device__ __forceinline__ unsigned xb_add(unsigned* p, unsigned v) { return __hip_atomic_fetch_add(p, v, __ATOMIC_RELAXED, __HIP_MEMORY_SCOPE_AGENT); }
__device__ __forceinline__ unsigned xb_xcc_id() { return (unsigned)__builtin_amdgcn_s_getreg((3 << 11) | 20) & 0xFu; }
#define XB_SPIN(cond, bar) do { unsigned _sp = 0; while (cond) { __builtin_amdgcn_s_sleep(1); \
    if ((++_sp & 255u) == 0u) { if (xb_ld(&(bar)[XB_TMO])) break; if (_sp > XB_SPIN_CAP) { atomicAdd(&(bar)[XB_TMO], 1u); break; } } } } while (0)
struct XcdBarrier { unsigned* bar; unsigned x; volatile LAS unsigned* st; };
__device__ __forceinline__ XcdBarrier xcd_barrier_post(unsigned* bar, volatile LAS unsigned* st) {
    XcdBarrier b; b.bar = bar; b.x = xb_xcc_id(); b.st = st;
    if (threadIdx.x == 0) (void)xb_add(&bar[XB_XCNT(b.x)], 1u);
    return b;
}
__device__ __forceinline__ void xcd_barrier_complete(unsigned* bar, unsigned x, unsigned& nloc, unsigned& nx) {
    const unsigned G = gridDim.x * gridDim.y * gridDim.z;
    unsigned sum, cnt, mine, sp = 0u;
    for (;;) {
        sum = 0u; cnt = 0u; mine = 0u;
#pragma unroll
        for (unsigned j = 0; j < 16; ++j) { const unsigned c = xb_ld(&bar[XB_XCNT(j)]); sum += c; cnt += (c > 0u) ? 1u : 0u; mine = (j == x) ? c : mine; }
        if (sum == G) break;
        __builtin_amdgcn_s_sleep(1);
        if ((++sp & 255u) == 0u) { if (xb_ld(&bar[XB_TMO])) break; if (sp > XB_SPIN_CAP) { atomicAdd(&bar[XB_TMO], 1u); break; } }
    }
    nloc = mine > 0u ? mine : 1u; nx = cnt > 0u ? cnt : 1u;
}
__device__ __forceinline__ void xcd_barrier(const XcdBarrier& b) {
    asm volatile("s_waitcnt vmcnt(0)" ::: "memory");
    __syncthreads();
    if (threadIdx.x == 0) {
        unsigned* bar = b.bar;
        __builtin_amdgcn_s_waitcnt(0);
        unsigned nloc = b.st[0], nx = b.st[1];
        if (nloc == 0u) { xcd_barrier_complete(bar, b.x, nloc, nx); b.st[0] = nloc; b.st[1] = nx; }
        const unsigned old = xb_add(&bar[XB_XSUB(b.x)], 1u);
        const unsigned gen = old / nloc;
        if (old + 1u == (gen + 1u) * nloc) {
            __builtin_amdgcn_fence(__ATOMIC_RELEASE, "agent");
            asm volatile("s_waitcnt vmcnt(0)" ::: "memory");
            const unsigned og = xb_add(&bar[XB_TOP], 1u);
            const unsigned tg = og / nx;
            if (og + 1u == (tg + 1u) * nx) xb_add(&bar[XB_TOPGEN], 1u);
            else XB_SPIN(xb_ld(&bar[XB_TOPGEN]) == tg, bar);
            __builtin_amdgcn_fence(__ATOMIC_ACQUIRE, "agent");
            xb_add(&bar[XB_XGEN(b.x)], 1u);
            asm volatile("s_waitcnt vmcnt(0)" ::: "memory");
        } else {
            XB_SPIN(xb_ld(&bar[XB_XGEN(b.x)]) == gen, bar);
            __builtin_amdgcn_fence(__ATOMIC_ACQUIRE, "agent");
            asm volatile("s_waitcnt vmcnt(0)" ::: "memory");
        }
    }
    __syncthreads();
}

struct Frame {
    LAS unsigned char* lds;
    int tid, lane, wave, G, bid;
    const float *xp, *xs, *cache_k, *cache_v, *state_conv, *state_ssm, *c_prompt, *c_sample, *w_ada, *b_ada, *g_pre_mix, *g_post_mix, *w_in, *sinks, *g_att,
        *conv_w, *conv_b, *dt_bias, *a_log, *d_skip, *g_ssm, *w_out, *g_pre_ffn, *g_post_ffn, *w_gate, *w_up, *w_down;
    float* out;
    signed char *U8, *Wgu8, *H8, *Wd8, *Win8, *U18; float *ASC, *WSC, *HSC, *WSCD, *ASC1, *WSC1;
    bf16 *X1, *WinT, *WoutT, *WguT, *WdT, *U, *PROJ, *MIX, *MIXOUT, *HB, *FB, *HPREV;
    float *MODP, *MODF, *DT, *SSQA, *SSQS, *SSQ2, *SSQ4, *SSQ2S, *SSQ4S, *TAIL, *DECAY, *WDT; bf16* STATES;
};

struct TrItem { const float* src; bf16* dst; int ldw, ldt; };
constexpr int TI_IN = 4096, TI_OUT = 2048, TI_G = 5632, TI_U = 5632, TI_D = 5632;
__device__ __forceinline__ TrItem tr_decode(const Frame& F, int it) {
    TrItem t;
    if (it < TI_IN) { const int kb = it >> 7, nb = it & 127; t.src = F.w_in + (size_t)(64 * kb) * INW + 32 * nb; t.ldw = INW; t.dst = F.WinT + (size_t)(32 * nb) * DM + 64 * kb; t.ldt = DM; return t; } it -= TI_IN;
    if (it < TI_OUT) { const int kb = it >> 6, nb = it & 63; t.src = F.w_out + (size_t)(64 * kb) * DM + 32 * nb; t.ldw = DM; t.dst = F.WoutT + (size_t)(32 * nb) * DM + 64 * kb; t.ldt = DM; return t; } it -= TI_OUT;
    if (it < TI_G) { const int kb = it / 176, nb = it % 176, n0 = 32 * nb; t.src = F.w_gate + (size_t)(64 * kb) * DFF + n0; t.ldw = DFF; t.dst = F.WguT + (size_t)((n0 >> 7) * 256 + (n0 & 127)) * DM + 64 * kb; t.ldt = DM; return t; } it -= TI_G;
    if (it < TI_U) { const int kb = it / 176, nb = it % 176, n0 = 32 * nb; t.src = F.w_up + (size_t)(64 * kb) * DFF + n0; t.ldw = DFF; t.dst = F.WguT + (size_t)((n0 >> 7) * 256 + 128 + (n0 & 127)) * DM + 64 * kb; t.ldt = DM; return t; } it -= TI_U;
    { const int kb = it >> 6, nb = it & 63; t.src = F.w_down + (size_t)(64 * kb) * DM + 32 * nb; t.ldw = DM; t.dst = F.WdT + (size_t)(32 * nb) * DFF + 64 * kb; t.ldt = DFF; return t; }
}
__device__ __forceinline__ void tr_load(const TrItem& t, int lane, float (&tv)[32]) {
    const float* p = t.src + (size_t)(lane >> 5) * t.ldw + (lane & 31);
#pragma unroll
    for (int i = 0; i < 32; ++i) tv[i] = __builtin_nontemporal_load(p + (size_t)(2 * i) * t.ldw);
}
__device__ __forceinline__ void tr_store(const TrItem& t, int lane, const float (&tv)[32], LAS float* scr) {
#pragma unroll
    for (int i = 0; i < 32; ++i) { const int kk = 2 * i + (lane >> 5); scr[kk * 33 + (lane & 31)] = tv[i]; }
    LDS_WAIT(); asm volatile("" ::: "memory");
    const int c = lane & 7;
#pragma unroll
    for (int j = 0; j < 4; ++j) { const int n = (lane >> 3) + 8 * j; const LAS float* s = scr + (8 * c) * 33 + n;
        u32x4 o; o.x = cvtpk(s[0 * 33], s[1 * 33]); o.y = cvtpk(s[2 * 33], s[3 * 33]); o.z = cvtpk(s[4 * 33], s[5 * 33]); o.w = cvtpk(s[6 * 33], s[7 * 33]);
        *(u32x4*)(t.dst + (size_t)n * t.ldt + 8 * c) = o; }
    LDS_WAIT(); asm volatile("" ::: "memory");
}
__device__ __forceinline__ void transpose_range(Frame& F, int base, int first, int end, int step, LAS float* scr) {
    int it = first; if (it >= end) return;
    float ta[32], tb[32];
    TrItem ia = tr_decode(F, base + it), ib = ia;
    tr_load(ia, F.lane, ta);
#pragma unroll 1
    for (; it < end; it += 2 * step) {
        const int i1 = it + step, i2 = i1 + step;
        if (i1 < end) { ib = tr_decode(F, base + i1); tr_load(ib, F.lane, tb); }
        tr_store(ia, F.lane, ta, scr);
        if (i2 < end) { ia = tr_decode(F, base + i2); tr_load(ia, F.lane, ta); }
        if (i1 < end) tr_store(ib, F.lane, tb, scr);
    }
}
__device__ __forceinline__ void mod_kslab(Frame& F, int vb, int cs0, int ncs) {
    LAS unsigned char* lds = F.lds;
    const int tid = F.tid, lane = F.lane, w = F.wave, fr = lane & 15, fq = lane >> 4, nf = w & 3, kh = w >> 2;
    const int kslab = vb & 7, cgroup = vb >> 3, k0 = kslab * 256;
#pragma unroll 3
    for (int i = 0; i < 9; ++i) {
        const int id = tid + 512 * i, row = id >> 5, ch = id & 31;
        f32x4 a = (f32x4){0.f, 0.f, 0.f, 0.f}, b = a;
        if (row <= 128) { const float* src = (row < 128 ? F.c_sample + (size_t)row * DM : F.c_prompt) + k0 + 8 * ch; a = *(const f32x4*)src; b = *(const f32x4*)(src + 4); }
        u32x4 o; o.x = cvtpk(a[0] / (1.f + __expf(-a[0])), a[1] / (1.f + __expf(-a[1]))); o.y = cvtpk(a[2] / (1.f + __expf(-a[2])), a[3] / (1.f + __expf(-a[3])));
        o.z = cvtpk(b[0] / (1.f + __expf(-b[0])), b[1] / (1.f + __expf(-b[1]))); o.w = cvtpk(b[2] / (1.f + __expf(-b[2])), b[3] / (1.f + __expf(-b[3])));
        *(LAS u32x4*)(lds + row * 512 + ((ch ^ (row & 15)) * 16)) = o;
    }
    __syncthreads();
    LAS unsigned char* tile = lds + 73728 + w * 2048;
    LAS f32x4* red = (LAS f32x4*)(lds + 90112);
    float* outp = F.MODP + (size_t)kslab * 129 * 12288;
    const float* wbase = F.w_ada + (size_t)(k0 + kh * 128 + (lane >> 2)) * 12288 + (lane & 3) * 4 + 16 * nf;
    f32x4 wv[4][2], wn[4][2];
    const int csb = cs0 + cgroup * ncs;
    { const float* wp = wbase + csb * 64;
#pragma unroll
      for (int sx = 0; sx < 4; ++sx) { wn[sx][0] = __builtin_nontemporal_load((const f32x4*)(wp + (size_t)(32 * sx) * 12288)); wn[sx][1] = __builtin_nontemporal_load((const f32x4*)(wp + (size_t)(32 * sx + 16) * 12288)); } }
#pragma unroll 1
    for (int u = 0; u < ncs; ++u) {
        const int n0 = (csb + u) * 64 + 16 * nf;
#pragma unroll
        for (int sx = 0; sx < 4; ++sx) { wv[sx][0] = wn[sx][0]; wv[sx][1] = wn[sx][1]; }
        if (u + 1 < ncs) { const float* wp = wbase + (csb + u + 1) * 64;
#pragma unroll
            for (int sx = 0; sx < 4; ++sx) { wn[sx][0] = __builtin_nontemporal_load((const f32x4*)(wp + (size_t)(32 * sx) * 12288)); wn[sx][1] = __builtin_nontemporal_load((const f32x4*)(wp + (size_t)(32 * sx + 16) * 12288)); } }
        f32x4 acc[9];
#pragma unroll
        for (int i = 0; i < 9; ++i) acc[i] = (f32x4){0.f, 0.f, 0.f, 0.f};
#pragma unroll
        for (int sp = 0; sp < 2; ++sp) {
#pragma unroll
            for (int t = 0; t < 2; ++t) { const int sx = 2 * sp + t; LAS unsigned char* tb = tile + t * 1024;
                *(LAS u32x2*)(tb + (lane >> 2) * 32 + (lane & 3) * 8) = (u32x2){cvtpk(wv[sx][0][0], wv[sx][0][1]), cvtpk(wv[sx][0][2], wv[sx][0][3])};
                *(LAS u32x2*)(tb + (16 + (lane >> 2)) * 32 + (lane & 3) * 8) = (u32x2){cvtpk(wv[sx][1][0], wv[sx][1][1]), cvtpk(wv[sx][1][2], wv[sx][1][3])}; }
            LDS_WAIT();
#pragma unroll
            for (int t = 0; t < 2; ++t) { const int sx = 2 * sp + t; const LAS unsigned char* tb = tile + t * 1024;
                unsigned e[8];
#pragma unroll
                for (int j = 0; j < 8; ++j) e[j] = *(const LAS unsigned short*)(tb + (8 * fq + j) * 32 + fr * 2);
                const u32x4 bw = (u32x4){e[0] | (e[1] << 16), e[2] | (e[3] << 16), e[4] | (e[5] << 16), e[6] | (e[7] << 16)};
                const bf16x8 bfrag = __builtin_bit_cast(bf16x8, bw);
                const int chunk = kh * 16 + 4 * sx + fq;
#pragma unroll
                for (int mf = 0; mf < 9; ++mf) { const bf16x8 af = *(const LAS bf16x8*)(lds + (16 * mf + fr) * 512 + ((chunk ^ fr) * 16));
                    acc[mf] = __builtin_amdgcn_mfma_f32_16x16x32_bf16(bfrag, af, acc[mf], 0, 0, 0); } }
            LDS_WAIT();
        }
        if (kh == 1) {
#pragma unroll
            for (int mf = 0; mf < 9; ++mf) red[(nf * 9 + mf) * 64 + lane] = acc[mf];
        }
        __syncthreads();
        if (kh == 0) {
#pragma unroll
            for (int mf = 0; mf < 9; ++mf) { const int m = 16 * mf + fr; const f32x4 o = acc[mf] + red[(nf * 9 + mf) * 64 + lane];
                if (m < 129) *(f32x4*)(outp + (size_t)m * 12288 + n0 + 4 * fq) = o; }
        }
        __syncthreads();
    }
}
__device__ __forceinline__ f32x4 mod4(const Frame& F, int mrow, int idx4) {
    f32x4 s = ((const f32x4*)F.b_ada)[idx4];
    const f32x4* p = (const f32x4*)F.MODP + (size_t)mrow * 3072 + idx4;
#pragma unroll
    for (int k = 0; k < 8; ++k) s += __builtin_nontemporal_load(p + (size_t)k * 129 * 3072);
    return s;
}
__device__ __forceinline__ void ph0(Frame& F) {
    const int gt = F.bid * 512 + F.tid, NT = F.G * 512;
    for (int i = gt; i < 16 * DM; i += NT) { const int h = i & 15, k = i >> 4; F.WDT[h * DM + k] = F.w_in[(size_t)k * INW + NPROJ + h]; }
    for (int vb = F.bid; vb < 256; vb += F.G) mod_kslab(F, vb, 0, 2);
    LAS float* scr = (LAS float*)(F.lds + F.wave * 16384);
    transpose_range(F, 0, F.bid * 8 + F.wave, TI_IN + TI_OUT, F.G * 8, scr);
}
__device__ __forceinline__ void prep_late(Frame& F) {
    for (int vb = F.bid; vb < 256; vb += F.G) mod_kslab(F, vb, 64, 4);
    LAS float* scr = (LAS float*)(F.lds + F.wave * 16384);
    transpose_range(F, TI_IN + TI_OUT, F.bid * 8 + F.wave, TI_G + TI_U + TI_D, F.G * 8, scr);
    __syncthreads();
}

template <int NCH>
__device__ __forceinline__ void quant_row(const bf16* src, signed char* dst, float* scale_out, int lane) {
    const u32x4* s4 = (const u32x4*)src; u32x4 v[NCH]; float amax = 0.f;
#pragma unroll
    for (int j = 0; j < NCH; ++j) { v[j] = __builtin_nontemporal_load(s4 + lane + 64 * j);
#pragma unroll
        for (int e = 0; e < 4; ++e) amax = fmaxf(amax, fmaxf(fabsf(bflo(v[j][e])), fabsf(bfhi(v[j][e])))); }
    amax = fmaxf(wave_max(amax), 1e-30f);
    const float qs = 127.0f / amax;
    if (lane == 0) *scale_out = amax * (1.0f / 127.0f);
    u32x2* d = (u32x2*)dst;
#pragma unroll
    for (int j = 0; j < NCH; ++j) d[lane + 64 * j] = (u32x2){pack_i8(bflo(v[j].x) * qs, bfhi(v[j].x) * qs, bflo(v[j].y) * qs, bfhi(v[j].y) * qs), pack_i8(bflo(v[j].z) * qs, bfhi(v[j].z) * qs, bflo(v[j].w) * qs, bfhi(v[j].w) * qs)};
}
__device__ __forceinline__ void row_load8(const float* p, int lane, f32x4 (&x)[8]) {
    const f32x4* xr = (const f32x4*)p;
#pragma unroll
    for (int j = 0; j < 8; ++j) x[j] = __builtin_nontemporal_load(xr + lane + 64 * j);
}
__device__ __forceinline__ void dt_from_row(const Frame& F, int r, const f32x4 (&v)[8], const LAS f32x4* W4) {
    const int lane = F.lane;
    float p[16];
#pragma unroll
    for (int h = 0; h < 16; ++h) p[h] = 0.f;
#pragma unroll
    for (int j = 0; j < 8; ++j) {
#pragma unroll
        for (int hg = 0; hg < 2; ++hg) {
            f32x4 w[8];
#pragma unroll
            for (int i = 0; i < 8; ++i) w[i] = W4[(hg * 8 + i) * 512 + lane + 64 * j];
#pragma unroll
            for (int i = 0; i < 8; ++i) p[hg * 8 + i] += (v[j][0] * w[i][0] + v[j][1] * w[i][1]) + (v[j][2] * w[i][2] + v[j][3] * w[i][3]);
            __builtin_amdgcn_sched_barrier(0);
        }
    }
    float q8[8], q4[4], q2[2], q1;
    { const bool up = (lane & 32) != 0;
#pragma unroll
      for (int i = 0; i < 8; ++i) { const float send = up ? p[i] : p[i + 8], keep = up ? p[i + 8] : p[i]; q8[i] = keep + __shfl_xor(send, 32); } }
    { const bool up = (lane & 16) != 0;
#pragma unroll
      for (int i = 0; i < 4; ++i) { const float send = up ? q8[i] : q8[i + 4], keep = up ? q8[i + 4] : q8[i]; q4[i] = keep + __shfl_xor(send, 16); } }
    { const bool up = (lane & 8) != 0;
#pragma unroll
      for (int i = 0; i < 2; ++i) { const float send = up ? q4[i] : q4[i + 2], keep = up ? q4[i + 2] : q4[i]; q2[i] = keep + __shfl_xor(send, 8); } }
    { const bool up = (lane & 4) != 0; const float send = up ? q2[0] : q2[1], keep = up ? q2[1] : q2[0]; q1 = keep + __shfl_xor(send, 4); }
    q1 += __shfl_xor(q1, 2); q1 += __shfl_xor(q1, 1);
    if ((lane & 3) == 0) { const int h = ((lane >> 5) & 1) * 8 + ((lane >> 4) & 1) * 4 + ((lane >> 3) & 1) * 2 + ((lane >> 2) & 1);
        const float x = q1 + F.dt_bias[h]; F.DT[(size_t)r * 16 + h] = x > 20.f ? x : log1pf(expf(x)); }
}
template <bool LDSP>
__device__ __forceinline__ void ph1_proc(const Frame& F, int r, f32x4 (&v)[8], int mrow, const LAS f32x4* W4, const LAS f32x4* PT) {
    const int lane = F.lane; float ss = 0.f;
#pragma unroll
    for (int j = 0; j < 8; ++j) ss += (v[j][0] * v[j][0] + v[j][1] * v[j][1]) + (v[j][2] * v[j][2] + v[j][3] * v[j][3]);
    ss = wave_sum(ss);
    const float rs = 1.0f / sqrtf(ss * (1.0f / DM) + EPS);
    u32x2* orow = (u32x2*)(F.U + (size_t)r * DM);
#pragma unroll
    for (int j = 0; j < 8; ++j) {
        f32x4 pa, pb;
        if (LDSP) { pa = PT[lane + 64 * j]; pb = PT[512 + lane + 64 * j]; }
        else { pa = ((const f32x4*)F.g_pre_mix)[lane + 64 * j] * (mod4(F, mrow, 512 + lane + 64 * j) + 1.0f); pb = mod4(F, mrow, lane + 64 * j); }
        v[j] = (v[j] * rs) * pa + pb; orow[lane + 64 * j] = (u32x2){cvtpk(v[j][0], v[j][1]), cvtpk(v[j][2], v[j][3])};
        if (!LDSP && (j & 1)) asm volatile("" ::: "memory"); }
    if (LDSP) {
        float amax = 0.f;
#pragma unroll
        for (int j = 0; j < 8; ++j) amax = fmaxf(amax, fmaxf(fmaxf(fabsf(v[j][0]), fabsf(v[j][1])), fmaxf(fabsf(v[j][2]), fabsf(v[j][3]))));
        amax = fmaxf(wave_max(amax), 1e-20f);
        const float qs = 127.0f / amax;
        if (lane == 0) F.ASC1[r] = amax * (1.0f / 127.0f);
        unsigned* o8 = (unsigned*)(F.U18 + (size_t)r * DM);
#pragma unroll
        for (int j = 0; j < 8; ++j) o8[lane + 64 * j] = pack_i8(v[j][0] * qs, v[j][1] * qs, v[j][2] * qs, v[j][3] * qs);
    }
    dt_from_row(F, r, v, W4);
}
__device__ __forceinline__ void ph1(Frame& F) {
    LAS f32x4* W4 = (LAS f32x4*)F.lds;
    LAS f32x4* PT = (LAS f32x4*)(F.lds + P1PRM_OFF);
    for (int i = F.tid; i < 16 * 512; i += 512) W4[i] = ((const f32x4*)F.WDT)[i];
    { const int i = F.tid; PT[i] = ((const f32x4*)F.g_pre_mix)[i] * (mod4(F, 128, 512 + i) + 1.0f); PT[512 + i] = mod4(F, 128, i); }
    __syncthreads();
    const int gw = F.bid * 8 + F.wave, NGW = F.G * 8, lane = F.lane;
    {
        f32x4 xa[8], xb[8];
        int r = gw;
        if (r < LP) row_load8(F.xp + (size_t)r * DM, lane, xa);
#pragma unroll 1
        for (; r < LP; r += 2 * NGW) {
            const int r1 = r + NGW, r2 = r1 + NGW;
            if (r1 < LP) row_load8(F.xp + (size_t)r1 * DM, lane, xb);
            ph1_proc<true>(F, r, xa, 128, W4, PT);
            if (r2 < LP) row_load8(F.xp + (size_t)r2 * DM, lane, xa);
            if (r1 < LP) ph1_proc<true>(F, r1, xb, 128, W4, PT);
        }
    }
    for (int n = gw; n < NPROJ; n += NGW) quant_row<4>(F.WinT + (size_t)n * DM, F.Win8 + (size_t)n * DM, F.WSC1 + n, lane);
    for (int r = LP + gw; r < MT; r += NGW) {
        f32x4 v[8];
        row_load8(F.xs + (size_t)(r - LP) * DM, lane, v);
        ph1_proc<false>(F, r, v, r - LP, W4, PT);
    }
}

template <int NCH>
__device__ __forceinline__ void conv_block(const bf16* base, int pitch, bool halo_valid, const float* cw, const float* cb, float (&out)[8][NCH]) {
    float w[4][NCH], b[NCH];
#pragma unroll
    for (int e = 0; e < NCH; e += 4) {
        const f32x4 bb = *(const f32x4*)(cb + e);
#pragma unroll
        for (int q = 0; q < 4; ++q) b[e + q] = bb[q];
#pragma unroll
        for (int i = 0; i < 4; ++i) { const f32x4 ww = *(const f32x4*)(cw + i * CONVD + e);
#pragma unroll
            for (int q = 0; q < 4; ++q) w[i][e + q] = ww[q]; }
    }
#pragma unroll
    for (int tt = 0; tt < 8; ++tt)
#pragma unroll
        for (int e = 0; e < NCH; ++e) out[tt][e] = b[e];
#pragma unroll
    for (int i = 0; i < 11; ++i) {
        float r[NCH];
        if (i < 3 && !halo_valid) {
#pragma unroll
            for (int e = 0; e < NCH; ++e) r[e] = 0.f;
        } else {
            if constexpr (NCH == 8) { const u32x4 q = __builtin_nontemporal_load((const u32x4*)(base + (long)i * pitch));
                r[0] = bflo(q.x); r[1] = bfhi(q.x); r[2] = bflo(q.y); r[3] = bfhi(q.y); r[4] = bflo(q.z); r[5] = bfhi(q.z); r[6] = bflo(q.w); r[7] = bfhi(q.w); }
            else { const u32x2 q = *(const u32x2*)(base + (long)i * pitch); r[0] = bflo(q.x); r[1] = bfhi(q.x); r[2] = bflo(q.y); r[3] = bfhi(q.y); }
        }
#pragma unroll
        for (int tt = 0; tt < 8; ++tt) { const int j = i - tt; if (j >= 0 && j <= 3) {
#pragma unroll
            for (int e = 0; e < NCH; ++e) out[tt][e] += w[j][e] * r[e]; } }
    }
#pragma unroll
    for (int tt = 0; tt < 8; ++tt)
#pragma unroll
        for (int e = 0; e < NCH; ++e) out[tt][e] = silu_f(out[tt][e]);
}
__device__ __forceinline__ void conv8_load(const bf16* base, int pitch, bool halo_valid, u32x4 (&raw)[11]) {
#pragma unroll
    for (int i = 0; i < 11; ++i) { raw[i] = (u32x4){0u, 0u, 0u, 0u}; if (i >= 3 || halo_valid) raw[i] = *(const u32x4*)(base + (long)i * pitch); }
}
__device__ __forceinline__ void conv8_apply(const u32x4 (&raw)[11], const float* cw, const float* cb, float (&out)[8][8]) {
    float w[4][8], b[8];
#pragma unroll
    for (int e = 0; e < 8; e += 4) { const f32x4 bb = *(const f32x4*)(cb + e);
#pragma unroll
        for (int q = 0; q < 4; ++q) b[e + q] = bb[q];
#pragma unroll
        for (int i = 0; i < 4; ++i) { const f32x4 ww = *(const f32x4*)(cw + i * CONVD + e);
#pragma unroll
            for (int q = 0; q < 4; ++q) w[i][e + q] = ww[q]; } }
#pragma unroll
    for (int tt = 0; tt < 8; ++tt)
#pragma unroll
        for (int e = 0; e < 8; ++e) out[tt][e] = b[e];
#pragma unroll
    for (int i = 0; i < 11; ++i) {
        const float r[8] = {bflo(raw[i].x), bfhi(raw[i].x), bflo(raw[i].y), bfhi(raw[i].y), bflo(raw[i].z), bfhi(raw[i].z), bflo(raw[i].w), bfhi(raw[i].w)};
#pragma unroll
        for (int tt = 0; tt < 8; ++tt) { const int j = i - tt; if (j >= 0 && j <= 3) {
#pragma unroll
            for (int e = 0; e < 8; ++e) out[tt][e] += w[j][e] * r[e]; } }
    }
#pragma unroll
    for (int tt = 0; tt < 8; ++tt)
#pragma unroll
        for (int e = 0; e < 8; ++e) out[tt][e] = silu_f(out[tt][e]);
}
__device__ __forceinline__ void conv4_load(const bf16* base, int pitch, bool halo_valid, u32x2 (&raw)[11]) {
#pragma unroll
    for (int i = 0; i < 11; ++i) { raw[i] = (u32x2){0u, 0u}; if (i >= 3 || halo_valid) raw[i] = __builtin_nontemporal_load((const u32x2*)(base + (long)i * pitch)); }
}
__device__ __forceinline__ void conv4_apply(const u32x2 (&raw)[11], const float* cw, const float* cb, float (&out)[8][4]) {
    float w[4][4], b[4];
    { const f32x4 bb = *(const f32x4*)cb;
#pragma unroll
      for (int q = 0; q < 4; ++q) b[q] = bb[q];
#pragma unroll
      for (int i = 0; i < 4; ++i) { const f32x4 ww = *(const f32x4*)(cw + i * CONVD);
#pragma unroll
          for (int q = 0; q < 4; ++q) w[i][q] = ww[q]; } }
#pragma unroll
    for (int tt = 0; tt < 8; ++tt)
#pragma unroll
        for (int e = 0; e < 4; ++e) out[tt][e] = b[e];
#pragma unroll
    for (int i = 0; i < 11; ++i) {
        const float r[4] = {bflo(raw[i].x), bfhi(raw[i].x), bflo(raw[i].y), bfhi(raw[i].y)};
#pragma unroll
        for (int tt = 0; tt < 8; ++tt) { const int j = i - tt; if (j >= 0 && j <= 3) {
#pragma unroll
            for (int e = 0; e < 4; ++e) out[tt][e] += w[j][e] * r[e]; } }
    }
#pragma unroll
    for (int tt = 0; tt < 8; ++tt)
#pragma unroll
        for (int e = 0; e < 4; ++e) out[tt][e] = silu_f(out[tt][e]);
}
__device__ __forceinline__ float chunk_acum(const Frame& F, int c, int h, float& d0, float& d1, float& ac0, float& ac1) {
    const float a = -expf(F.a_log[h]);
    const int t = c * 128 + 2 * F.lane;
    d0 = F.DT[(size_t)t * 16 + h]; d1 = F.DT[(size_t)(t + 1) * 16 + h];
    float v = (d0 + d1) * a;
#pragma unroll
    for (int o = 1; o < 64; o <<= 1) { const float n = __shfl_up(v, o); if (F.lane >= o) v += n; }
    ac1 = v; ac0 = v - d1 * a;
    return __shfl(v, 63);
}

__device__ __forceinline__ void ssd_a_item(Frame& F, int c, int g) {
    LAS unsigned char* lds = F.lds;
    const int lane = F.lane, hh = F.wave, h = g * 8 + hh, t0 = c * 128;
    LAS float* coef = (LAS float*)(lds + 98304) + hh * 128;
    u32x4 rawB[11], rawX[11];
    const int bco = F.tid & 15, bto = (F.tid >> 4) & 15, xco = lane & 3, xto = lane >> 2;
    if (F.tid < 256) conv8_load(F.PROJ + proj_b(g) + (long)(t0 + 8 * bto - 3) * 128 + 8 * bco, 128, (c > 0) || (bto > 0), rawB);
    conv8_load(F.PROJ + proj_x(h) + (long)(t0 + 8 * xto - 3) * 64 + 8 * xco, 64, (c > 0) || (xto > 0), rawX);
    {
        float d0, d1, ac0, ac1; const float tot = chunk_acum(F, c, h, d0, d1, ac0, ac1);
        coef[2 * lane] = d0 * __expf(tot - ac0); coef[2 * lane + 1] = d1 * __expf(tot - ac1);
        if (lane == 0) F.DECAY[c * 16 + h] = __expf(tot);
    }
    if (F.tid < 256) {
        const int co = bco, to = bto; float o[8][8];
        const int ch = 1024 + g * 128 + 8 * co;
        conv8_apply(rawB, F.conv_w + ch, F.conv_b + ch, o);
#pragma unroll
        for (int e = 0; e < 8; ++e) { const int n = 8 * co + e;
            u32x4 w; w.x = cvtpk(o[0][e], o[1][e]); w.y = cvtpk(o[2][e], o[3][e]); w.z = cvtpk(o[4][e], o[5][e]); w.w = cvtpk(o[6][e], o[7][e]);
            *(LAS u32x4*)(lds + n * 256 + ((to ^ (n & 15)) * 16)) = w; }
    }
    __syncthreads();
    LAS unsigned char* xt = lds + 32768 + hh * 8192;
    const int fr = lane & 15, fq = lane >> 4;
#pragma unroll 1
    for (int ph = 0; ph < 2; ++ph) {
        {
            const int co = xco, to = xto; float o[8][8];
            const int ch = h * 64 + 32 * ph + 8 * co;
            conv8_apply(rawX, F.conv_w + ch, F.conv_b + ch, o);
            if (ph == 0) conv8_load(F.PROJ + proj_x(h) + (long)(t0 + 8 * xto - 3) * 64 + 32 + 8 * xco, 64, (c > 0) || (xto > 0), rawX);
            float cf[8];
#pragma unroll
            for (int tt = 0; tt < 8; ++tt) cf[tt] = coef[8 * to + tt];
#pragma unroll
            for (int e = 0; e < 8; ++e) { const int pl = 8 * co + e;
                u32x4 w; w.x = cvtpk(o[0][e] * cf[0], o[1][e] * cf[1]); w.y = cvtpk(o[2][e] * cf[2], o[3][e] * cf[3]); w.z = cvtpk(o[4][e] * cf[4], o[5][e] * cf[5]); w.w = cvtpk(o[6][e] * cf[6], o[7][e] * cf[7]);
                *(LAS u32x4*)(xt + pl * 256 + ((to ^ (pl & 15)) * 16)) = w; }
        }
        LDS_WAIT();
        f32x4 acc[8][2];
#pragma unroll
        for (int nf = 0; nf < 8; ++nf) { acc[nf][0] = (f32x4){0.f, 0.f, 0.f, 0.f}; acc[nf][1] = (f32x4){0.f, 0.f, 0.f, 0.f}; }
#pragma unroll
        for (int ks = 0; ks < 4; ++ks) {
            bf16x8 xb[2];
#pragma unroll
            for (int pf = 0; pf < 2; ++pf) { const int p = 16 * pf + fr; xb[pf] = *(const LAS bf16x8*)(xt + p * 256 + (((4 * ks + fq) ^ (p & 15)) * 16)); }
#pragma unroll
            for (int nf = 0; nf < 8; ++nf) { const int n = 16 * nf + fr; const bf16x8 ba = *(const LAS bf16x8*)(lds + n * 256 + (((4 * ks + fq) ^ (n & 15)) * 16));
                acc[nf][0] = __builtin_amdgcn_mfma_f32_16x16x32_bf16(ba, xb[0], acc[nf][0], 0, 0, 0);
                acc[nf][1] = __builtin_amdgcn_mfma_f32_16x16x32_bf16(ba, xb[1], acc[nf][1], 0, 0, 0); }
        }
        bf16* sb = F.STATES + ((size_t)(c * 16 + h) * 64 + 32 * ph) * 128;
#pragma unroll
        for (int nf = 0; nf < 8; ++nf)
#pragma unroll
            for (int pf = 0; pf < 2; ++pf) *(u32x2*)(sb + (size_t)(16 * pf + fr) * 128 + 16 * nf + 4 * fq) = (u32x2){cvtpk(acc[nf][pf][0], acc[nf][pf][1]), cvtpk(acc[nf][pf][2], acc[nf][pf][3])};
        LDS_WAIT();
    }
    __syncthreads();
}

__device__ __forceinline__ void attn_stage(Frame& F, int qb, int kvh, LAS unsigned char* lds) {
    const int tid = F.tid;
    if (tid >= 256) {
        const int t2 = tid - 256;
#pragma unroll
        for (int i = 0; i < 8; ++i) { const int idx = t2 + 256 * i, key = idx >> 3, ch = idx & 7; const int row = qb * 128 - 128 + key;
            u32x4 v = (u32x4){0u, 0u, 0u, 0u};
            if (row >= 0) v = *(const u32x4*)(F.PROJ + proj_k(kvh) + (size_t)row * 64 + ch * 8);
            *(LAS u32x4*)(lds + key * 128 + ((ch ^ ((key >> 1) & 7)) * 16)) = v; }
    } else {
        const int ko = tid >> 3, dq = tid & 7; u32x4 v[8];
#pragma unroll
        for (int i = 0; i < 8; ++i) { const int row = qb * 128 - 128 + 8 * ko + i; v[i] = (u32x4){0u, 0u, 0u, 0u};
            if (row >= 0) v[i] = *(const u32x4*)(F.PROJ + proj_v(kvh) + (size_t)row * 64 + dq * 8); }
#pragma unroll
        for (int e = 0; e < 8; ++e) { const int d = 8 * dq + e; u32x4 w;
            const int sh = (e & 1) * 16;
#define VSEL(i) ((e < 2 ? v[i].x : e < 4 ? v[i].y : e < 6 ? v[i].z : v[i].w) >> sh & 0xffffu)
            w.x = VSEL(0) | (VSEL(1) << 16); w.y = VSEL(2) | (VSEL(3) << 16); w.z = VSEL(4) | (VSEL(5) << 16); w.w = VSEL(6) | (VSEL(7) << 16);
#undef VSEL
            *(LAS u32x4*)(lds + 32768 + d * 512 + ((ko ^ (d & 31)) * 16)) = w; }
    }
}
__device__ __forceinline__ void attn_compute(Frame& F, int qb, int kvh, LAS unsigned char* lds) {
    const int lane = F.lane;
    const int g = F.wave >> 1, head = kvh * 4 + g, qhalf = F.wave & 1, ql = lane & 31, hi = lane >> 5;
    const float slope2 = LOG2E * exp2f(-0.5f * (float)(head + 1)), sink2 = F.sinks[head] * LOG2E;
    const f32x4* ga4 = (const f32x4*)(F.g_att + head * 64);
#pragma unroll 1
    for (int pass = 0; pass < 2; ++pass) {
        const int a0 = qhalf * 64 + pass * 32, a = a0 + ql; const size_t qrow = (size_t)qb * 128 + a;
        bf16x8 qf[4];
#pragma unroll
        for (int ks = 0; ks < 4; ++ks) qf[ks] = *(const bf16x8*)(F.PROJ + proj_q(head) + qrow * 64 + 16 * ks + 8 * hi);
        f32x16 st[5];
#pragma unroll
        for (int kt = 0; kt < 5; ++kt) {
            f32x16 s = {};
            const int key = a0 + 32 * kt + ql;
#pragma unroll
            for (int ks = 0; ks < 4; ++ks) { const bf16x8 kf = *(const LAS bf16x8*)(lds + key * 128 + (((2 * ks + hi) ^ ((key >> 1) & 7)) * 16));
                s = __builtin_amdgcn_mfma_f32_32x32x16_bf16(kf, qf[ks], s, 0, 0, 0); }
            st[kt] = s;
        }
        float m = sink2;
#pragma unroll
        for (int kt = 0; kt < 5; ++kt)
#pragma unroll
            for (int r = 0; r < 16; ++r) { const int j = a0 + 32 * kt + (r & 3) + 8 * (r >> 2) + 4 * hi; const int dist = a + 128 - j;
                const bool valid = (dist >= 0) && (dist < 128) && (qb > 0 || j >= 128);
                const float s2 = valid ? st[kt][r] * (0.125f * LOG2E) - slope2 * (float)dist : -INFINITY;
                st[kt][r] = s2; m = fmaxf(m, s2); }
        m = fmaxf(m, __shfl_xor(m, 32));
        float l = 0.f;
#pragma unroll
        for (int kt = 0; kt < 5; ++kt)
#pragma unroll
            for (int r = 0; r < 16; ++r) { const float p = __builtin_amdgcn_exp2f(st[kt][r] - m); st[kt][r] = p; l += p; }
        l += __shfl_xor(l, 32);
        l += __builtin_amdgcn_exp2f(sink2 - m);
        f32x16 o0 = {}, o1 = {};
#pragma unroll
        for (int kt = 0; kt < 5; ++kt)
#pragma unroll
            for (int s = 0; s < 2; ++s) {
                u32x4 pw; pw.x = cvtpk(st[kt][8 * s + 0], st[kt][8 * s + 1]); pw.y = cvtpk(st[kt][8 * s + 2], st[kt][8 * s + 3]); pw.z = cvtpk(st[kt][8 * s + 4], st[kt][8 * s + 5]); pw.w = cvtpk(st[kt][8 * s + 6], st[kt][8 * s + 7]);
                const bf16x8 pf = __builtin_bit_cast(bf16x8, pw);
                const int kc = ((a0 + 32 * kt) >> 3) + 2 * s;
#pragma unroll
                for (int db = 0; db < 2; ++db) { const int d = 32 * db + ql;
                    const u32x2 lo = *(const LAS u32x2*)(lds + 32768 + d * 512 + ((kc ^ (d & 31)) * 16) + 8 * hi);
                    const u32x2 hi2 = *(const LAS u32x2*)(lds + 32768 + d * 512 + (((kc + 1) ^ (d & 31)) * 16) + 8 * hi);
                    const u32x4 vw = (u32x4){lo.x, lo.y, hi2.x, hi2.y};
                    const bf16x8 vf = __builtin_bit_cast(bf16x8, vw);
                    if (db == 0) o0 = __builtin_amdgcn_mfma_f32_32x32x16_bf16(vf, pf, o0, 0, 0, 0); else o1 = __builtin_amdgcn_mfma_f32_32x32x16_bf16(vf, pf, o1, 0, 0, 0); }
            }
        const float inv = 1.0f / l; float ssq = 0.f;
#pragma unroll
        for (int r = 0; r < 16; ++r) { o0[r] *= inv; o1[r] *= inv; ssq += o0[r] * o0[r] + o1[r] * o1[r]; }
        ssq += __shfl_xor(ssq, 32);
        if (hi == 0) F.SSQA[qrow * 16 + head] = ssq;
        bf16* orow = F.MIX + qrow * DM + head * 64;
#pragma unroll
        for (int rq = 0; rq < 4; ++rq) {
            const int d0 = 8 * rq + 4 * hi;
            { const f32x4 gg = ga4[d0 >> 2]; *(u32x2*)(orow + d0) = (u32x2){cvtpk(o0[4 * rq] * gg[0], o0[4 * rq + 1] * gg[1]), cvtpk(o0[4 * rq + 2] * gg[2], o0[4 * rq + 3] * gg[3])}; }
            { const f32x4 gg = ga4[(32 + d0) >> 2]; *(u32x2*)(orow + 32 + d0) = (u32x2){cvtpk(o1[4 * rq] * gg[0], o1[4 * rq + 1] * gg[1]), cvtpk(o1[4 * rq + 2] * gg[2], o1[4 * rq + 3] * gg[3])}; }
        }
    }
}

__device__ __forceinline__ void sample_attn_pair(Frame& F, int item0) {
    const int lane = F.lane, w = F.wave, it = item0 + (w >> 2), kq = w & 3, b = it >> 2, kvh = it & 3;
    LAS float* pl = (LAS float*)(F.lds + w * 512);
    LAS float* part = (LAS float*)(F.lds + 4096 + w * 1088);
    const float* trow = F.TAIL + (size_t)(128 + b) * NPROJ;
    const float* q = trow + C_Q + kvh * 256;
    const float* Kc = F.cache_k + ((size_t)b * 128 * 4 + kvh) * 64; const float* Vc = F.cache_v + ((size_t)b * 128 * 4 + kvh) * 64;
    float* Ko = F.out + O_KS + ((size_t)b * 128 * 4 + kvh) * 64; float* Vo = F.out + O_VS + ((size_t)b * 128 * 4 + kvh) * 64;
    const int key = 32 * kq + (lane & 31), dh = lane >> 5;
    f32x4 kv[8];
#pragma unroll
    for (int i = 0; i < 8; ++i) kv[i] = __builtin_nontemporal_load((const f32x4*)(Kc + (size_t)key * 256 + 32 * dh + 4 * i));
    float vv[32];
#pragma unroll
    for (int j = 0; j < 32; ++j) vv[j] = __builtin_nontemporal_load(Vc + (size_t)(32 * kq + j) * 256 + lane);
    float s[4] = {0.f, 0.f, 0.f, 0.f};
#pragma unroll
    for (int i = 0; i < 8; ++i) {
        if (key >= 1) *(f32x4*)(Ko + (size_t)(key - 1) * 256 + 32 * dh + 4 * i) = kv[i];
#pragma unroll
        for (int g = 0; g < 4; ++g) { const f32x4 qv = *(const f32x4*)(q + g * 64 + 32 * dh + 4 * i);
            s[g] += (kv[i][0] * qv[0] + kv[i][1] * qv[1]) + (kv[i][2] * qv[2] + kv[i][3] * qv[3]); }
    }
    float mloc[4], lloc[4];
#pragma unroll
    for (int g = 0; g < 4; ++g) {
        const int head = kvh * 4 + g; const float slope2 = LOG2E * exp2f(-0.5f * (float)(head + 1));
        float sc = s[g] + __shfl_xor(s[g], 32);
        sc = (key >= 1) ? sc * (0.125f * LOG2E) - slope2 * (float)(128 - key) : -INFINITY;
        float m = sc;
#pragma unroll
        for (int o = 1; o < 32; o <<= 1) m = fmaxf(m, __shfl_xor(m, o));
        m = fmaxf(m, -1e30f);
        const float p = __builtin_amdgcn_exp2f(sc - m);
        float l = p;
#pragma unroll
        for (int o = 1; o < 32; o <<= 1) l += __shfl_xor(l, o);
        if (dh == 0) pl[(lane & 31) * 4 + g] = p;
        mloc[g] = m; lloc[g] = l;
    }
    LDS_WAIT();
    float o[4] = {0.f, 0.f, 0.f, 0.f};
#pragma unroll
    for (int j = 0; j < 32; ++j) {
        const int kj = 32 * kq + j;
        if (kj >= 1) Vo[(size_t)(kj - 1) * 256 + lane] = vv[j];
        const f32x4 pj = *(const LAS f32x4*)(pl + j * 4);
        o[0] += pj[0] * vv[j]; o[1] += pj[1] * vv[j]; o[2] += pj[2] * vv[j]; o[3] += pj[3] * vv[j];
    }
    if (lane < 4) { part[lane] = (lane == 0) ? mloc[0] : (lane == 1) ? mloc[1] : (lane == 2) ? mloc[2] : mloc[3];
                    part[4 + lane] = (lane == 0) ? lloc[0] : (lane == 1) ? lloc[1] : (lane == 2) ? lloc[2] : lloc[3]; }
#pragma unroll
    for (int g = 0; g < 4; ++g) part[16 + g * 64 + lane] = o[g];
    __syncthreads();
    if (kq == 0) {
        const float kn = trow[C_K + kvh * 64 + lane], vn = trow[C_V + kvh * 64 + lane];
        Ko[127 * 256 + lane] = kn; Vo[127 * 256 + lane] = vn;
        const size_t row = (size_t)LP + b;
#pragma unroll
        for (int g = 0; g < 4; ++g) {
            const int head = kvh * 4 + g; const float sink2 = F.sinks[head] * LOG2E;
            const float sn = wave_sum(kn * q[g * 64 + lane]) * (0.125f * LOG2E);
            float m = fmaxf(sn, sink2);
#pragma unroll
            for (int qq = 0; qq < 4; ++qq) m = fmaxf(m, part[qq * 272 + g]);
            float l = __builtin_amdgcn_exp2f(sn - m) + __builtin_amdgcn_exp2f(sink2 - m), ov = __builtin_amdgcn_exp2f(sn - m) * vn;
#pragma unroll
            for (int qq = 0; qq < 4; ++qq) { const float f = __builtin_amdgcn_exp2f(part[qq * 272 + g] - m); l += f * part[qq * 272 + 4 + g]; ov += f * part[qq * 272 + 16 + g * 64 + lane]; }
            ov = ov / l;
            const float ssq = wave_sum(ov * ov);
            if (lane == 0) F.SSQA[row * 16 + head] = ssq;
            F.MIX[row * DM + head * 64 + lane] = (bf16)(cvtpk(ov * F.g_att[head * 64 + lane], 0.f) & 0xffffu);
        }
    }
    __syncthreads();
}
__device__ __forceinline__ void sample_ssd_item(Frame& F, int b, int h) {
    const int lane = F.lane, g = h >> 3, nq = lane & 15, prow = lane >> 4;
    const float* trow = F.TAIL + (size_t)(128 + b) * NPROJ;
    const float* sc = F.state_conv + (size_t)b * 3 * CONVD;
    float xs_l;
    { const int ch = h * 64 + lane;
      float y = F.conv_b[ch] + sc[ch] * F.conv_w[ch] + sc[CONVD + ch] * F.conv_w[CONVD + ch] + sc[2 * CONVD + ch] * F.conv_w[2 * CONVD + ch] + trow[C_X + ch] * F.conv_w[3 * CONVD + ch];
      xs_l = silu_f(y); }
    float Bv[8], Cv[8];
#pragma unroll
    for (int e = 0; e < 8; ++e) {
        { const int ch = 1024 + g * 128 + 8 * nq + e;
          float y = F.conv_b[ch] + sc[ch] * F.conv_w[ch] + sc[CONVD + ch] * F.conv_w[CONVD + ch] + sc[2 * CONVD + ch] * F.conv_w[2 * CONVD + ch] + trow[C_X + ch] * F.conv_w[3 * CONVD + ch];
          Bv[e] = silu_f(y); }
        { const int ch = 1280 + g * 128 + 8 * nq + e;
          float y = F.conv_b[ch] + sc[ch] * F.conv_w[ch] + sc[CONVD + ch] * F.conv_w[CONVD + ch] + sc[2 * CONVD + ch] * F.conv_w[2 * CONVD + ch] + trow[C_X + ch] * F.conv_w[3 * CONVD + ch];
          Cv[e] = silu_f(y); }
    }
    const size_t row = (size_t)LP + b;
    const float dt = F.DT[row * 16 + h], a = -expf(F.a_log[h]), dec = expf(dt * a), dsk = F.d_skip[h];
    const float* h0 = F.state_ssm + ((size_t)(b * 16 + h) * 64) * 128; float* ho = F.out + O_HS + ((size_t)(b * 16 + h) * 64) * 128;
    float ykeep = 0.f;
#pragma unroll 4
    for (int st = 0; st < 16; ++st) {
        const int p = 4 * st + prow; const float xp = __shfl(xs_l, p) * dt;
        const f32x4 a0 = __builtin_nontemporal_load((const f32x4*)(h0 + (size_t)p * 128 + 8 * nq)), a1 = __builtin_nontemporal_load((const f32x4*)(h0 + (size_t)p * 128 + 8 * nq + 4));
        f32x4 n0, n1; float part = 0.f;
#pragma unroll
        for (int e = 0; e < 4; ++e) { n0[e] = a0[e] * dec + xp * Bv[e]; n1[e] = a1[e] * dec + xp * Bv[4 + e]; part += n0[e] * Cv[e] + n1[e] * Cv[4 + e]; }
        *(f32x4*)(ho + (size_t)p * 128 + 8 * nq) = n0; *(f32x4*)(ho + (size_t)p * 128 + 8 * nq + 4) = n1;
        part += __shfl_xor(part, 1); part += __shfl_xor(part, 2); part += __shfl_xor(part, 4); part += __shfl_xor(part, 8);
        if (nq == st) ykeep = part;
    }
    const int pm = 4 * nq + prow;
    const float xm = __shfl(xs_l, pm), z = trow[C_Z + h * 64 + pm];
    const float y = (ykeep + dsk * xm) * silu_f(z);
    const float ssq = wave_sum(y * y);
    if (lane == 0) F.SSQS[row * 16 + h] = ssq;
    F.MIX[row * DM + 1024 + h * 64 + pm] = (bf16)(cvtpk(y * F.g_ssm[h * 64 + pm], 0.f) & 0xffffu);
}

__device__ __forceinline__ void ph3(Frame& F) {
    for (int rep = 0; rep < 1 + ((PROBE_SUB >> 0) & 1); ++rep)
    for (int it = F.bid; it < 256; it += F.G) ssd_a_item(F, it >> 1, it & 1);
    for (int rep = 0; rep < 1 + ((PROBE_SUB >> 1) & 1); ++rep)
    for (int it = F.bid; it < 512; it += 2 * F.G) {
        const int it2 = it + F.G;
        attn_stage(F, it >> 2, it & 3, F.lds);
        if (it2 < 512) attn_stage(F, it2 >> 2, it2 & 3, F.lds + 65536);
        __syncthreads();
        attn_compute(F, it >> 2, it & 3, F.lds);
        if (it2 < 512) attn_compute(F, it2 >> 2, it2 & 3, F.lds + 65536);
        __syncthreads();
    }
    for (int rep = 0; rep < 1 + ((PROBE_SUB >> 2) & 1); ++rep)
    for (int wi = F.bid * 8 + F.wave; wi < NB * 16; wi += F.G * 8) sample_ssd_item(F, wi >> 4, wi & 15);
    for (int rep = 0; rep < 1 + ((PROBE_SUB >> 3) & 1); ++rep)
    for (int it = F.bid; it < NB * 2; it += F.G) sample_attn_pair(F, 2 * it);
    for (int i = F.bid * 512 + F.tid; i < 129 * 2048; i += F.G * 512) { const int m = i >> 11, c = i & 2047; ((f32x4*)F.MODF)[i] = mod4(F, m, 1024 + c); }
    const int gt = F.bid * 512 + F.tid, NT = F.G * 512;
    for (int i = gt; i < 32768; i += NT) { const int j = i >> 8, cc = i & 255; F.out[O_KP + i] = F.TAIL[(size_t)j * NPROJ + C_K + cc]; F.out[O_VP + i] = F.TAIL[(size_t)j * NPROJ + C_V + cc]; }
    for (int i = gt; i < 3 * CONVD; i += NT) { const int r = i / CONVD, ch = i % CONVD; F.out[O_CP + i] = F.TAIL[(size_t)(125 + r) * NPROJ + C_X + ch]; }
    for (int i = gt; i < NB * 3 * CONVD; i += NT) { const int b = i / (3 * CONVD), r = (i / CONVD) % 3, ch = i % CONVD;
        F.out[O_CS + i] = (r < 2) ? F.state_conv[(size_t)(b * 3 + r + 1) * CONVD + ch] : F.TAIL[(size_t)(128 + b) * NPROJ + C_X + ch]; }
}

__device__ __forceinline__ void ph4(Frame& F) {
    for (int e = F.bid * 512 + F.tid; e < 131072; e += F.G * 512) {
        const int h = e >> 13; float hv = 0.f;
#pragma unroll 1
        for (int c0 = 0; c0 < 128; c0 += 32) {
            float s[32], d[32];
#pragma unroll
            for (int i = 0; i < 32; ++i) { s[i] = __uint_as_float((unsigned)__builtin_nontemporal_load(F.STATES + (size_t)(c0 + i) * 131072 + e) << 16); d[i] = F.DECAY[(c0 + i) * 16 + h]; }
#pragma unroll
            for (int i = 0; i < 32; ++i) { F.HPREV[(size_t)(c0 + i) * 131072 + e] = (bf16)(cvtpk(hv, 0.f) & 0xffffu); hv = hv * d[i] + s[i]; }
        }
        F.out[O_HP + e] = hv;
    }
}

__device__ __forceinline__ void ssd_c_item(Frame& F, int c, int g) {
    LAS unsigned char* lds = F.lds;
    const int lane = F.lane, w = F.wave, tid = F.tid, t0 = c * 128, fr = lane & 15, fq = lane >> 4;
    LAS float* acl = (LAS float*)(lds + 98304); LAS float* dtl = (LAS float*)(lds + 102400);
    {
        float d0, d1, ac0, ac1; (void)chunk_acum(F, c, g * 8 + w, d0, d1, ac0, ac1);
        acl[w * 128 + 2 * lane] = ac0; acl[w * 128 + 2 * lane + 1] = ac1; dtl[w * 128 + 2 * lane] = d0; dtl[w * 128 + 2 * lane + 1] = d1;
    }
    {
        const int isC = tid >> 8, t2 = tid & 255, co = t2 & 15, to = t2 >> 4; float o[8][8];
        const int ch = (isC ? 1280 : 1024) + g * 128 + 8 * co;
        conv_block<8>(F.PROJ + (isC ? proj_c(g) : proj_b(g)) + (long)(t0 + 8 * to - 3) * 128 + 8 * co, 128, (c > 0) || (to > 0), F.conv_w + ch, F.conv_b + ch, o);
        LAS unsigned char* img = lds + (isC ? 0 : 32768);
#pragma unroll
        for (int tt = 0; tt < 8; ++tt) { const int t = 8 * to + tt;
            u32x4 wv; wv.x = cvtpk(o[tt][0], o[tt][1]); wv.y = cvtpk(o[tt][2], o[tt][3]); wv.z = cvtpk(o[tt][4], o[tt][5]); wv.w = cvtpk(o[tt][6], o[tt][7]);
            *(LAS u32x4*)(img + t * 256 + ((co ^ (t & 15)) * 16)) = wv; }
    }
    __syncthreads();
    f32x4 cb[8];
#pragma unroll
    for (int sf = 0; sf < 8; ++sf) cb[sf] = (f32x4){0.f, 0.f, 0.f, 0.f};
    {
        const int l = 16 * w + fr;
#pragma unroll
        for (int ks = 0; ks < 4; ++ks) {
            const bf16x8 cf = *(const LAS bf16x8*)(lds + l * 256 + (((4 * ks + fq) ^ (l & 15)) * 16));
#pragma unroll
            for (int sf = 0; sf < 8; ++sf) if (sf <= w) { const int s = 16 * sf + fr;
                const bf16x8 bfr = *(const LAS bf16x8*)(lds + 32768 + s * 256 + (((4 * ks + fq) ^ (s & 15)) * 16));
                cb[sf] = __builtin_amdgcn_mfma_f32_16x16x32_bf16(bfr, cf, cb[sf], 0, 0, 0); }
        }
    }
    __syncthreads();
    const int l = 16 * w + fr; const size_t trow = (size_t)t0 + l;
    const int co4 = tid & 15, cto = (tid >> 4) & 15;
    u32x2 rawc[11], rawn[11];
    if (tid < 256) conv4_load(F.PROJ + proj_x(g * 8) + (long)(t0 + 8 * cto - 3) * 64 + 4 * co4, 64, (c > 0) || (cto > 0), rawc);
    const int hp_p = tid >> 3, hp_c = (tid & 7) * 2;
    u32x4 hq0, hq1; u32x2 zw[4], zn[4];
    { const bf16* hp = F.HPREV + ((size_t)(c * 16 + g * 8) * 64) * 128 + (size_t)hp_p * 128 + hp_c * 8;
      hq0 = *(const u32x4*)hp; hq1 = *(const u32x4*)(hp + 8);
      const bf16* zp = F.PROJ + proj_z(g * 8) + trow * 64;
#pragma unroll
      for (int pf = 0; pf < 4; ++pf) zn[pf] = __builtin_nontemporal_load((const u32x2*)(zp + 16 * pf + 4 * fq));
      *(LAS u32x4*)(lds + 106496 + hp_p * 256 + ((hp_c ^ (hp_p & 15)) * 16)) = hq0; *(LAS u32x4*)(lds + 106496 + hp_p * 256 + (((hp_c + 1) ^ (hp_p & 15)) * 16)) = hq1; }
    __syncthreads();
#pragma unroll 1
    for (int hh = 0; hh < 8; ++hh) {
        const int h = g * 8 + hh;
        if (hh < 7) {
            const bf16* hp = F.HPREV + ((size_t)(c * 16 + h + 1) * 64) * 128 + (size_t)hp_p * 128 + hp_c * 8;
            hq0 = *(const u32x4*)hp; hq1 = *(const u32x4*)(hp + 8);
        }
#pragma unroll
        for (int pf = 0; pf < 4; ++pf) zw[pf] = zn[pf];
        if (hh < 7) { const bf16* zp = F.PROJ + proj_z(h + 1) + trow * 64;
#pragma unroll
            for (int pf = 0; pf < 4; ++pf) zn[pf] = __builtin_nontemporal_load((const u32x2*)(zp + 16 * pf + 4 * fq)); }
        if (tid < 256 && hh < 7) conv4_load(F.PROJ + proj_x(h + 1) + (long)(t0 + 8 * cto - 3) * 64 + 4 * co4, 64, (c > 0) || (cto > 0), rawn);
        {
            const float al = acl[hh * 128 + l];
#pragma unroll
            for (int sf = 0; sf < 8; ++sf) if (sf <= (w | 1)) {
                const int s0 = 16 * sf + 4 * fq; float mv[4];
#pragma unroll
                for (int r = 0; r < 4; ++r) { const int sx = s0 + r; mv[r] = (sf <= w && sx <= l) ? cb[sf][r] * __expf(al - acl[hh * 128 + sx]) : 0.f; }
                *(LAS u32x2*)(lds + 32768 + l * 256 + (((s0 >> 3) ^ (l & 15)) * 16) + (s0 & 7) * 2) = (u32x2){cvtpk(mv[0], mv[1]), cvtpk(mv[2], mv[3])};
            }
        }
        f32x4 y1[4], y2[4];
#pragma unroll
        for (int pf = 0; pf < 4; ++pf) { y1[pf] = (f32x4){0.f, 0.f, 0.f, 0.f}; y2[pf] = (f32x4){0.f, 0.f, 0.f, 0.f}; }
#pragma unroll
        for (int ks = 0; ks < 4; ++ks) {
            const bf16x8 cf = *(const LAS bf16x8*)(lds + l * 256 + (((4 * ks + fq) ^ (l & 15)) * 16));
#pragma unroll
            for (int pf = 0; pf < 4; ++pf) { const int p = 16 * pf + fr; const bf16x8 hfr = *(const LAS bf16x8*)(lds + 106496 + p * 256 + (((4 * ks + fq) ^ (p & 15)) * 16));
                y2[pf] = __builtin_amdgcn_mfma_f32_16x16x32_bf16(hfr, cf, y2[pf], 0, 0, 0); }
        }
        if (tid < 256) {
            float o[8][4];
            const int ch = h * 64 + 4 * co4;
            conv4_apply(rawc, F.conv_w + ch, F.conv_b + ch, o);
#pragma unroll
            for (int tt = 0; tt < 8; ++tt) { const int t = 8 * cto + tt;
                *(LAS u32x2*)(lds + 81920 + t * 128 + co4 * 8) = (u32x2){cvtpk(o[tt][0], o[tt][1]), cvtpk(o[tt][2], o[tt][3])}; }
            float dv[8];
#pragma unroll
            for (int tt = 0; tt < 8; ++tt) dv[tt] = dtl[hh * 128 + 8 * cto + tt];
#pragma unroll
            for (int e = 0; e < 4; ++e) { const int p = 4 * co4 + e;
                u32x4 wv; wv.x = cvtpk(o[0][e] * dv[0], o[1][e] * dv[1]); wv.y = cvtpk(o[2][e] * dv[2], o[3][e] * dv[3]); wv.z = cvtpk(o[4][e] * dv[4], o[5][e] * dv[5]); wv.w = cvtpk(o[6][e] * dv[6], o[7][e] * dv[7]);
                *(LAS u32x4*)(lds + 65536 + p * 256 + ((cto ^ (p & 15)) * 16)) = wv; }
#pragma unroll
            for (int i = 0; i < 11; ++i) rawc[i] = rawn[i];
        }
        __syncthreads();
#pragma unroll
        for (int ks = 0; ks < 4; ++ks) {
            if (32 * ks <= 16 * w + 15) {
                const bf16x8 mf = *(const LAS bf16x8*)(lds + 32768 + l * 256 + (((4 * ks + fq) ^ (l & 15)) * 16));
#pragma unroll
                for (int pf = 0; pf < 4; ++pf) { const int p = 16 * pf + fr; const bf16x8 xf = *(const LAS bf16x8*)(lds + 65536 + p * 256 + (((4 * ks + fq) ^ (p & 15)) * 16));
                    y1[pf] = __builtin_amdgcn_mfma_f32_16x16x32_bf16(xf, mf, y1[pf], 0, 0, 0); }
            }
        }
        {
            const float ea = __expf(acl[hh * 128 + l]), dsk = F.d_skip[h]; float ssq = 0.f;
            bf16* op = F.MIX + trow * DM + 1024 + h * 64;
#pragma unroll
            for (int pf = 0; pf < 4; ++pf) { const int p0 = 16 * pf + 4 * fq;
                const u32x2 xw = *(const LAS u32x2*)(lds + 81920 + l * 128 + p0 * 2); const f32x4 gs = *(const f32x4*)(F.g_ssm + h * 64 + p0);
                const float xv[4] = {bflo(xw.x), bfhi(xw.x), bflo(xw.y), bfhi(xw.y)}, zv[4] = {bflo(zw[pf].x), bfhi(zw[pf].x), bflo(zw[pf].y), bfhi(zw[pf].y)};
                float yo[4];
#pragma unroll
                for (int r = 0; r < 4; ++r) { const float y = (y1[pf][r] + ea * y2[pf][r] + dsk * xv[r]) * silu_f(zv[r]); ssq += y * y; yo[r] = y * gs[r]; }
                *(u32x2*)(op + p0) = (u32x2){cvtpk(yo[0], yo[1]), cvtpk(yo[2], yo[3])}; }
            ssq += __shfl_xor(ssq, 16); ssq += __shfl_xor(ssq, 32);
            if (fq == 0) F.SSQS[trow * 16 + h] = ssq;
        }
        if (hh < 7) { *(LAS u32x4*)(lds + 106496 + hp_p * 256 + ((hp_c ^ (hp_p & 15)) * 16)) = hq0; *(LAS u32x4*)(lds + 106496 + hp_p * 256 + (((hp_c + 1) ^ (hp_p & 15)) * 16)) = hq1; }
        __syncthreads();
    }
}
__device__ __forceinline__ void ph5(Frame& F) {
    for (int it = F.bid; it < 256; it += F.G) ssd_c_item(F, it >> 1, it & 1);
}

template <int NF, int N, bool I8>
__device__ __forceinline__ void skinny_group(f32x4 (&acc)[NF][2], const bf16* const (&bp)[NF], const bf16* ap, int K) {
    bf16x8 bfr[N][NF], af[N][2];
#pragma unroll
    for (int i = 0; i < N; ++i) {
#pragma unroll
        for (int b = 0; b < NF; ++b) bfr[i][b] = *(const bf16x8*)(bp[b] + i * 32);
#pragma unroll
        for (int mf = 0; mf < 2; ++mf) af[i][mf] = *(const bf16x8*)(ap + (size_t)mf * 16 * K + i * 32);
    }
    __builtin_amdgcn_sched_barrier(0);
#pragma unroll
    for (int i = 0; i < N; ++i)
#pragma unroll
        for (int mf = 0; mf < 2; ++mf)
#pragma unroll
            for (int b = 0; b < NF; ++b) {
                if constexpr (I8) acc[b][mf] = __builtin_bit_cast(f32x4, __builtin_amdgcn_mfma_i32_16x16x64_i8(__builtin_bit_cast(i32x4, bfr[i][b]), __builtin_bit_cast(i32x4, af[i][mf]), __builtin_bit_cast(i32x4, acc[b][mf]), 0, 0, 0));
                else acc[b][mf] = __builtin_amdgcn_mfma_f32_16x16x32_bf16(bfr[i][b], af[i][mf], acc[b][mf], 0, 0, 0);
            }
    __builtin_amdgcn_sched_barrier(0);
}
template <int MODE, bool I8 = false>
__device__ __forceinline__ void skinny_units(Frame& F, const bf16* A, const bf16* Bt, int K, int ngroups) {
    constexpr int NF = (MODE == 1 || MODE == 3) ? 4 : 2;
    const int lane = F.lane, w = F.wave, fr = lane & 15, fq = lane >> 4, kw = K >> 3, nks = kw >> 5;
    LAS f32x4* red = (LAS f32x4*)F.lds;
    for (int unit = F.bid; unit < 4 * ngroups; unit += F.G) {
        const int mg = unit & 3, ng = unit >> 2;
        f32x4 acc[NF][2];
#pragma unroll
        for (int b = 0; b < NF; ++b) { acc[b][0] = (f32x4){0.f, 0.f, 0.f, 0.f}; acc[b][1] = (f32x4){0.f, 0.f, 0.f, 0.f}; }
        const bf16* bp[NF];
#pragma unroll
        for (int b = 0; b < NF; ++b) {
            int brow;
            if (MODE == 3) brow = (ng >> 2) * 256 + (ng & 3) * 32 + (b >> 1) * 128 + (b & 1) * 16;
            else brow = ng * (NF * 16) + b * 16;
            bp[b] = Bt + (size_t)(brow + fr) * K + w * kw + 8 * fq;
        }
        const bf16* ap = A + (size_t)(mg * 32 + fr) * K + w * kw + 8 * fq;
        int ks = 0;
        if (NF == 2) {
#pragma unroll 1
            for (; ks + 8 <= nks; ks += 8) { const bf16* bq[NF];
#pragma unroll
                for (int b = 0; b < NF; ++b) bq[b] = bp[b] + ks * 32;
                skinny_group<NF, (NF == 2 ? 8 : 1), I8>(acc, bq, ap + ks * 32, K); }
        }
#pragma unroll 1
        for (; ks + 4 <= nks; ks += 4) { const bf16* bq[NF];
#pragma unroll
            for (int b = 0; b < NF; ++b) bq[b] = bp[b] + ks * 32;
            skinny_group<NF, 4, I8>(acc, bq, ap + ks * 32, K); }
#pragma unroll 1
        for (; ks < nks; ++ks) { const bf16* bq[NF];
#pragma unroll
            for (int b = 0; b < NF; ++b) bq[b] = bp[b] + ks * 32;
            skinny_group<NF, 1, I8>(acc, bq, ap + ks * 32, K); }
#pragma unroll
        for (int b = 0; b < NF; ++b)
#pragma unroll
            for (int mf = 0; mf < 2; ++mf) red[((w * NF + b) * 2 + mf) * 64 + lane] = acc[b][mf];
        __syncthreads();
        {
            const int b = w >> 1, mf = w & 1, m = mg * 32 + mf * 16 + fr; const size_t row = (size_t)LP + m;
            const bool active = (MODE == 3) ? (w < 4) : (w < 2 * NF);
            if (active) {
                f32x4 s0 = (f32x4){0.f, 0.f, 0.f, 0.f}, s1 = (f32x4){0.f, 0.f, 0.f, 0.f};
#pragma unroll
                for (int ww = 0; ww < 8; ++ww) {
                    if (MODE == 3) { s0 += red[((ww * NF + b) * 2 + mf) * 64 + lane]; s1 += red[((ww * NF + b + 2) * 2 + mf) * 64 + lane]; }
                    else if (MODE == 2) { if (ww < 4) s0 += red[((ww * NF + b) * 2 + mf) * 64 + lane]; else s1 += red[((ww * NF + b) * 2 + mf) * 64 + lane]; }
                    else s0 += red[((ww * NF + b) * 2 + mf) * 64 + lane];
                }
                if (MODE == 1) {
                    const int col = ng * 64 + b * 16 + 4 * fq;
                    *(f32x4*)(F.TAIL + (size_t)(128 + m) * NPROJ + col) = s0;
                } else if (MODE == 3) {
                    const int col = ng * 32 + b * 16 + 4 * fq;
                    float h[4];
                    if (I8) {
                        i32x4 g0 = (i32x4){0, 0, 0, 0}, u0 = (i32x4){0, 0, 0, 0};
#pragma unroll
                        for (int ww = 0; ww < 8; ++ww) { g0 += __builtin_bit_cast(i32x4, red[((ww * NF + b) * 2 + mf) * 64 + lane]); u0 += __builtin_bit_cast(i32x4, red[((ww * NF + b + 2) * 2 + mf) * 64 + lane]); }
                        const int wrow = (ng >> 2) * 256 + (ng & 3) * 32 + b * 16 + 4 * fq; const float sa = F.ASC[row];
                        const f32x4 sg = *(const f32x4*)(F.WSC + wrow), su = *(const f32x4*)(F.WSC + wrow + 128);
#pragma unroll
                        for (int r = 0; r < 4; ++r) { s0[r] = (float)g0[r] * (sa * sg[r]); s1[r] = (float)u0[r] * (sa * su[r]); }
                    }
#pragma unroll
                    for (int r = 0; r < 4; ++r) h[r] = silu_f(s0[r]) * s1[r];
                    *(u32x2*)(F.HB + row * DFF + col) = (u32x2){cvtpk(h[0], h[1]), cvtpk(h[2], h[3])};
                } else {
                    f32x4 v = s0;
                    if (MODE == 4 && I8) {
                        i32x4 t0 = (i32x4){0, 0, 0, 0};
#pragma unroll
                        for (int ww = 0; ww < 8; ++ww) t0 += __builtin_bit_cast(i32x4, red[((ww * NF + b) * 2 + mf) * 64 + lane]);
                        const float sa = F.HSC[row]; const f32x4 wsd = *(const f32x4*)(F.WSCD + ng * 32 + b * 16 + 4 * fq);
#pragma unroll
                        for (int r = 0; r < 4; ++r) v[r] = (float)t0[r] * (sa * wsd[r]);
                    }
                    if (MODE == 2) {
                        const f32x4* pa = (const f32x4*)(F.SSQA + row * 16); const f32x4* ps = (const f32x4*)(F.SSQS + row * 16);
                        float sa = 0.f, ss = 0.f;
#pragma unroll
                        for (int i = 0; i < 4; ++i) { const f32x4 a = pa[i], c = ps[i]; sa += (a[0] + a[1]) + (a[2] + a[3]); ss += (c[0] + c[1]) + (c[2] + c[3]); }
                        const float ra = 1.0f / sqrtf(sa * (1.0f / 1024.0f) + EPS), rs = 1.0f / sqrtf(ss * (1.0f / 1024.0f) + EPS);
                        v = s0 * ra + s1 * rs;
                    }
                    const int col = ng * 32 + b * 16 + 4 * fq;
                    bf16* O = (MODE == 2) ? F.MIXOUT : F.FB; float* SQ = (MODE == 2) ? F.SSQ2S : F.SSQ4S;
                    *(u32x2*)(O + row * DM + col) = (u32x2){cvtpk(v[0], v[1]), cvtpk(v[2], v[3])};
                    float q = (v[0] * v[0] + v[1] * v[1]) + (v[2] * v[2] + v[3] * v[3]);
                    q += __shfl_xor(q, 16); q += __shfl_xor(q, 32);
                    if (fq == 0) SQ[m * 128 + ng * 2 + b] = q;
                }
            }
        }
        __syncthreads();
    }
}

struct P7In { f32x4 x[8]; u32x2 m[8]; float sq; };
__device__ __forceinline__ void p7_load(const Frame& F, int r, const float* xrow, P7In& in) {
    row_load8(xrow, F.lane, in.x);
    const u32x2* mo = (const u32x2*)(F.MIXOUT + (size_t)r * DM);
#pragma unroll
    for (int j = 0; j < 8; ++j) in.m[j] = __builtin_nontemporal_load(mo + F.lane + 64 * j);
    in.sq = (F.lane < 32) ? F.SSQ2[(size_t)r * 32 + F.lane] : 0.f;
}
template <bool LDSP>
__device__ __forceinline__ void p7_proc(const Frame& F, int r, P7In& in, const LAS f32x4* T, const f32x4* mod) {
    const int lane = F.lane;
    const float r1 = 1.0f / sqrtf(wave_sum(in.sq) * (1.0f / DM) + EPS);
    float ss = 0.f; u32x2* o1 = (u32x2*)(F.X1 + (size_t)r * DM);
#pragma unroll
    for (int j = 0; j < 8; ++j) {
        f32x4 cA; if (LDSP) cA = T[lane + 64 * j]; else cA = mod[lane + 64 * j] * ((const f32x4*)F.g_post_mix)[lane + 64 * j];
        const f32x4 mv = (f32x4){bflo(in.m[j].x), bfhi(in.m[j].x), bflo(in.m[j].y), bfhi(in.m[j].y)};
        const f32x4 v = in.x[j] + cA * (mv * r1); in.x[j] = v;
        ss += (v[0] * v[0] + v[1] * v[1]) + (v[2] * v[2] + v[3] * v[3]);
        o1[lane + 64 * j] = (u32x2){cvtpk(v[0], v[1]), cvtpk(v[2], v[3])};
    }
    const float r2 = 1.0f / sqrtf(wave_sum(ss) * (1.0f / DM) + EPS);
    float amax = 0.f;
#pragma unroll
    for (int j = 0; j < 8; ++j) {
        f32x4 cB, cC; if (LDSP) { cB = T[512 + lane + 64 * j]; cC = T[1024 + lane + 64 * j]; }
        else { cB = ((const f32x4*)F.g_pre_ffn)[lane + 64 * j] * (mod[2 * 512 + lane + 64 * j] + 1.0f); cC = mod[512 + lane + 64 * j]; }
        const f32x4 u = (in.x[j] * r2) * cB + cC; in.x[j] = u;
        amax = fmaxf(amax, fmaxf(fmaxf(fabsf(u[0]), fabsf(u[1])), fmaxf(fabsf(u[2]), fabsf(u[3]))));
    }
    amax = fmaxf(wave_max(amax), 1e-20f);
    const float qs = 127.0f / amax;
    if (lane == 0) F.ASC[r] = amax * (1.0f / 127.0f);
    unsigned* orow = (unsigned*)(F.U8 + (size_t)r * DM);
#pragma unroll
    for (int j = 0; j < 8; ++j) orow[lane + 64 * j] = pack_i8(in.x[j][0] * qs, in.x[j][1] * qs, in.x[j][2] * qs, in.x[j][3] * qs);
}
__device__ __forceinline__ void ph7(Frame& F) {
    LAS f32x4* T = (LAS f32x4*)F.lds;
    { const int i = F.tid; const f32x4* mod = (const f32x4*)(F.MODF + (size_t)128 * 8192);
      T[i] = mod[i] * ((const f32x4*)F.g_post_mix)[i]; T[512 + i] = ((const f32x4*)F.g_pre_ffn)[i] * (mod[2 * 512 + i] + 1.0f); T[1024 + i] = mod[512 + i]; }
    __syncthreads();
    const int gw = F.bid * 8 + F.wave, NGW = F.G * 8, lane = F.lane;
    for (int n = gw; n < 2 * DFF; n += NGW) quant_row<4>(F.WguT + (size_t)n * DM, F.Wgu8 + (size_t)n * DM, F.WSC + n, lane);
    for (int n = gw; n < DM; n += NGW) quant_row<11>(F.WdT + (size_t)n * DFF, F.Wd8 + (size_t)n * DFF, F.WSCD + n, lane);
    {
        P7In a, b; int r = gw;
        if (r < LP) p7_load(F, r, F.xp + (size_t)r * DM, a);
#pragma unroll 1
        for (; r < LP; r += 2 * NGW) {
            const int r1 = r + NGW, r2 = r1 + NGW;
            if (r1 < LP) p7_load(F, r1, F.xp + (size_t)r1 * DM, b);
            p7_proc<true>(F, r, a, T, nullptr);
            if (r2 < LP) p7_load(F, r2, F.xp + (size_t)r2 * DM, a);
            if (r1 < LP) p7_proc<true>(F, r1, b, T, nullptr);
        }
    }
    for (int r = LP + gw; r < MT; r += NGW) {
        P7In a; p7_load(F, r, F.xs + (size_t)(r - LP) * DM, a);
        a.sq = F.SSQ2S[(r - LP) * 128 + lane] + F.SSQ2S[(r - LP) * 128 + 64 + lane];
        p7_proc<false>(F, r, a, T, (const f32x4*)(F.MODF + (size_t)(r - LP) * 8192));
    }
}
__device__ __forceinline__ void ph_hq(Frame& F) {
    const int gw = F.bid * 8 + F.wave, NGW = F.G * 8;
#pragma unroll 1
    for (int r = gw; r < MT; r += NGW) quant_row<11>(F.HB + (size_t)r * DFF, F.H8 + (size_t)r * DFF, F.HSC + r, F.lane);
}
struct P10In { u32x2 x[8]; u32x2 f[8]; float sq; };
__device__ __forceinline__ void p10_load(const Frame& F, int r, P10In& in) {
    const u32x2* xo = (const u32x2*)(F.X1 + (size_t)r * DM); const u32x2* fo = (const u32x2*)(F.FB + (size_t)r * DM);
#pragma unroll
    for (int j = 0; j < 8; ++j) { in.x[j] = __builtin_nontemporal_load(xo + F.lane + 64 * j); in.f[j] = __builtin_nontemporal_load(fo + F.lane + 64 * j); }
    in.sq = (F.lane < 32) ? F.SSQ4[(size_t)r * 32 + F.lane] : 0.f;
}
template <bool SAMPLE>
__device__ __forceinline__ void p10_proc(const Frame& F, int r, P10In& in, const f32x4 (&cA)[8]) {
    const float r4 = 1.0f / sqrtf(wave_sum(in.sq) * (1.0f / DM) + EPS);
    f32x4* yr = (f32x4*)(F.out + O_Y + (size_t)r * DM);
#pragma unroll
    for (int j = 0; j < 8; ++j) {
        const f32x4 fv = (f32x4){bflo(in.f[j].x), bfhi(in.f[j].x), bflo(in.f[j].y), bfhi(in.f[j].y)};
        const f32x4 xv = (f32x4){bflo(in.x[j].x), bfhi(in.x[j].x), bflo(in.x[j].y), bfhi(in.x[j].y)};
        f32x4 c; if (SAMPLE) c = ((const f32x4*)(F.MODF + (size_t)(r - LP) * 8192))[3 * 512 + F.lane + 64 * j] * ((const f32x4*)F.g_post_ffn)[F.lane + 64 * j]; else c = cA[j];
        __builtin_nontemporal_store(xv + c * (fv * r4), yr + F.lane + 64 * j);
    }
}
__device__ __forceinline__ void ph10(Frame& F) {
    const int gw = F.bid * 8 + F.wave, NGW = F.G * 8, lane = F.lane;
    f32x4 cA[8];
#pragma unroll
    for (int j = 0; j < 8; ++j) cA[j] = ((const f32x4*)(F.MODF + (size_t)128 * 8192))[3 * 512 + lane + 64 * j] * ((const f32x4*)F.g_post_ffn)[lane + 64 * j];
    {
        P10In a, b; int r = gw;
        if (r < LP) p10_load(F, r, a);
#pragma unroll 1
        for (; r < LP; r += 2 * NGW) {
            const int r1 = r + NGW, r2 = r1 + NGW;
            if (r1 < LP) p10_load(F, r1, b);
            p10_proc<false>(F, r, a, cA);
            if (r2 < LP) p10_load(F, r2, a);
            if (r1 < LP) p10_proc<false>(F, r1, b, cA);
        }
    }
    for (int r = LP + gw; r < MT; r += NGW) {
        P10In a; p10_load(F, r, a); a.sq = F.SSQ4S[(r - LP) * 128 + lane] + F.SSQ4S[(r - LP) * 128 + 64 + lane]; p10_proc<true>(F, r, a, cA);
    }
}

constexpr int N_PHASES = 12;
struct Args { const float* in[27]; float* out; unsigned char* ws; int ph_lo, ph_hi; };
__global__ void __launch_bounds__(512, 2) mk_fwd(Args args) {
    extern __shared__ __attribute__((aligned(16))) unsigned char lds_raw[];
    Frame F;
    F.lds = (LAS unsigned char*)lds_raw;
    F.tid = threadIdx.x; F.lane = F.tid & 63; F.wave = __builtin_amdgcn_readfirstlane(F.tid >> 6);
    F.G = gridDim.x; F.bid = blockIdx.x;
    unsigned char* ws = args.ws;
    F.xp = args.in[0]; F.xs = args.in[1]; F.cache_k = args.in[2]; F.cache_v = args.in[3]; F.state_conv = args.in[4]; F.state_ssm = args.in[5]; F.c_prompt = args.in[6]; F.c_sample = args.in[7];
    F.w_ada = args.in[8]; F.b_ada = args.in[9]; F.g_pre_mix = args.in[10]; F.g_post_mix = args.in[11]; F.w_in = args.in[12]; F.sinks = args.in[13]; F.g_att = args.in[14];
    F.conv_w = args.in[15]; F.conv_b = args.in[16]; F.dt_bias = args.in[17]; F.a_log = args.in[18]; F.d_skip = args.in[19]; F.g_ssm = args.in[20]; F.w_out = args.in[21];
    F.g_pre_ffn = args.in[22]; F.g_post_ffn = args.in[23]; F.w_gate = args.in[24]; F.w_up = args.in[25]; F.w_down = args.in[26];
    F.out = args.out;
    F.X1 = (bf16*)(ws + WS_X1); F.U8 = (signed char*)(ws + WS_U8); F.Wgu8 = (signed char*)(ws + WS_WGU8); F.ASC = (float*)(ws + WS_ASC); F.WSC = (float*)(ws + WS_WSC); F.H8 = (signed char*)(ws + WS_H8); F.Wd8 = (signed char*)(ws + WS_WD8); F.HSC = (float*)(ws + WS_HSC); F.WSCD = (float*)(ws + WS_WSCD); F.Win8 = (signed char*)(ws + WS_WIN8); F.U18 = (signed char*)(ws + WS_U18); F.ASC1 = (float*)(ws + WS_ASC1); F.WSC1 = (float*)(ws + WS_WSC1); F.WinT = (bf16*)(ws + WS_WIN); F.WoutT = (bf16*)(ws + WS_WOUT); F.WguT = (bf16*)(ws + WS_WGU); F.WdT = (bf16*)(ws + WS_WD);
    F.U = (bf16*)(ws + WS_U); F.PROJ = (bf16*)(ws + WS_PROJ); F.MIX = (bf16*)(ws + WS_MIX); F.MIXOUT = (bf16*)(ws + WS_MIXOUT); F.HB = (bf16*)(ws + WS_H); F.FB = (bf16*)(ws + WS_F);
    F.HPREV = (bf16*)(ws + WS_HPREV);
    F.MODP = (float*)(ws + WS_MODP); F.MODF = (float*)(ws + WS_MODF); F.DT = (float*)(ws + WS_DT); F.SSQA = (float*)(ws + WS_SSQA); F.SSQS = (float*)(ws + WS_SSQS); F.SSQ2 = (float*)(ws + WS_SSQ2); F.SSQ4 = (float*)(ws + WS_SSQ4); F.SSQ2S = (float*)(ws + WS_SSQ2S); F.SSQ4S = (float*)(ws + WS_SSQ4S);
    F.TAIL = (float*)(ws + WS_TAIL); F.STATES = (bf16*)(ws + WS_STATES); F.DECAY = (float*)(ws + WS_DECAY); F.WDT = (float*)(ws + WS_WDT);

    for (int u = F.tid; u < (LDS_BYTES - LDSCTL_OFF) / 4; u += 512) ((LAS unsigned*)(F.lds + LDSCTL_OFF))[u] = 0u;
    __syncthreads();
    XcdBarrier bar; bar.bar = (unsigned*)(ws + WS_CTL) + CW_BAR; bar.x = 0; bar.st = nullptr;
    if (MK_N_LAUNCHES == 1) bar = xcd_barrier_post((unsigned*)(ws + WS_CTL) + CW_BAR, (volatile LAS unsigned*)(F.lds + MISC_OFF) + 8);
    const int lo = args.ph_lo, hi = args.ph_hi;
#define IN(k) (lo <= (k) && (k) < hi)
#define SEAM(k) do { if (IN(k) && IN((k) + 1)) xcd_barrier(bar); } while (0)

#define RUN_G1() do { if (F.bid & 1) prep_late(F); { pg8::Gemm g{(const bf16*)F.U18, (const bf16*)F.Win8, LP, 2048, DM / 2, 0x98763210ull}; pg8::StaticOrder S; S.init(LP, 2048, F.G, F.bid); pg8::EpiProj<true> E{F.PROJ, NPROJ, F.TAIL, F.ASC1, F.WSC1}; pg8::gemm_phase<pg8::EpiProj<true>, true, true>(F.lds, g, S, E); }   \
        { pg8::Gemm g{F.U, F.WinT, LP, 2048, DM, 0xFEDCBA54ull}; pg8::StaticOrder S; S.init(LP, 2048, F.G, F.bid); pg8::EpiProj<false> E{F.PROJ, NPROJ, F.TAIL, nullptr, nullptr}; pg8::gemm_phase<pg8::EpiProj<false>>(F.lds, g, S, E); }   \
        for (int rep_ = 0; rep_ < 1 + ((PROBE_SUB >> (7 + 1)) & 1); ++rep_) skinny_units<1>(F, F.U + (size_t)LP * DM, F.WinT, DM, NPROJ / 64); if (!(F.bid & 1)) prep_late(F); } while (0)
#define RUN_G2() do { if (F.bid & 1) { for (int rep_ = 0; rep_ < 1 + ((PROBE_SUB >> (7 + 2)) & 1); ++rep_) skinny_units<2>(F, F.MIX + (size_t)LP * DM, F.WoutT, DM, DM / 32); } { pg8::Gemm g{F.MIX, F.WoutT, LP, DM, DM, 0ull}; pg8::StaticOrder S; S.init(LP, DM, F.G, F.bid, 4); pg8::EpiRowSsq<true> E{F.MIXOUT, DM, F.SSQ2, F.SSQA, F.SSQS, nullptr, nullptr}; pg8::gemm_phase<pg8::EpiRowSsq<true>>(F.lds, g, S, E); } \
        if (!(F.bid & 1)) { for (int rep_ = 0; rep_ < 1 + ((PROBE_SUB >> (7 + 2)) & 1); ++rep_) skinny_units<2>(F, F.MIX + (size_t)LP * DM, F.WoutT, DM, DM / 32); } } while (0)
#define RUN_G3() do { if (F.bid & 1) { for (int rep_ = 0; rep_ < 1 + ((PROBE_SUB >> (7 + 3)) & 1); ++rep_) skinny_units<3, true>(F, (const bf16*)(F.U8 + (size_t)LP * DM), (const bf16*)F.Wgu8, DM / 2, DFF / 32); } { pg8::Gemm g{(const bf16*)F.U8, (const bf16*)F.Wgu8, LP, 2 * DFF, DM / 2, 0ull}; pg8::StaticOrder S; S.init(LP, 2 * DFF, F.G, F.bid); pg8::EpiSwiGLU E{F.HB, DFF, F.ASC, F.WSC}; pg8::gemm_phase<pg8::EpiSwiGLU, true, true>(F.lds, g, S, E); } \
        if (!(F.bid & 1)) { for (int rep_ = 0; rep_ < 1 + ((PROBE_SUB >> (7 + 3)) & 1); ++rep_) skinny_units<3, true>(F, (const bf16*)(F.U8 + (size_t)LP * DM), (const bf16*)F.Wgu8, DM / 2, DFF / 32); } } while (0)
#define RUN_G4() do { if (F.bid & 1) { for (int rep_ = 0; rep_ < 1 + ((PROBE_SUB >> (7 + 4)) & 1); ++rep_) skinny_units<4, true>(F, (const bf16*)(F.H8 + (size_t)LP * DFF), (const bf16*)F.Wd8, DFF / 2, DM / 32); } { pg8::Gemm g{(const bf16*)F.H8, (const bf16*)F.Wd8, LP, DM, DFF / 2, 0ull}; pg8::StaticOrder S; S.init(LP, DM, F.G, F.bid, 4); pg8::EpiRowSsq<false, true> E{F.FB, DM, F.SSQ4, nullptr, nullptr, F.HSC, F.WSCD}; pg8::gemm_phase<pg8::EpiRowSsq<false, true>, true, true>(F.lds, g, S, E); } \
        if (!(F.bid & 1)) { for (int rep_ = 0; rep_ < 1 + ((PROBE_SUB >> (7 + 4)) & 1); ++rep_) skinny_units<4, true>(F, (const bf16*)(F.H8 + (size_t)LP * DFF), (const bf16*)F.Wd8, DFF / 2, DM / 32); } } while (0)
#define PHASE(k, BODY) do { if (IN(k)) { BODY; if (PROBE_MASK & (1u << (k))) { xcd_barrier(bar); BODY; } } SEAM(k); if ((PROBE_SUB >> 7) & 1) SEAM(k); } while (0)
    PHASE(0, ph0(F));
    PHASE(1, ph1(F));
    PHASE(2, RUN_G1());
    PHASE(3, ph3(F));
    PHASE(4, ph4(F));
    PHASE(5, ph5(F));
    PHASE(6, RUN_G2());
    PHASE(7, ph7(F));
    PHASE(8, RUN_G3());
    PHASE(9, ph_hq(F));
    PHASE(10, RUN_G4());
    PHASE(11, ph10(F));
#undef IN
#undef SEAM
}

extern "C" void kernel_launch(void* const* d_in, const int* in_sizes, int n_in, void* d_out, int out_size, void* d_ws, size_t ws_size, hipStream_t stream) {
    static int grid = 0;
    if (grid == 0) {
        if (n_in != 27 || ws_size < WS_END) { fprintf(stderr, "kernel_launch: unexpected n_in %d / ws %zu\n", n_in, ws_size); grid = -1; return; }
        int dev = 0, cus = 0;
        if (hipGetDevice(&dev) != hipSuccess || hipDeviceGetAttribute(&cus, hipDeviceAttributeMultiprocessorCount, dev) != hipSuccess) { grid = -1; return; }
        if (hipFuncSetAttribute((const void*)mk_fwd, hipFuncAttributeMaxDynamicSharedMemorySize, LDS_BYTES) != hipSuccess) { fprintf(stderr, "kernel_launch: hipFuncSetAttribute failed\n"); grid = -1; return; }
        int per_cu = 0;
        (void)hipOccupancyMaxActiveBlocksPerMultiprocessor(&per_cu, (const void*)mk_fwd, 512, LDS_BYTES);
        (void)hipGetLastError();
        if (per_cu < 1) fprintf(stderr, "kernel_launch: occupancy query reports %d blocks per CU\n", per_cu);
        grid = cus;
    }
    if (grid < 0) return;
    (void)hipMemsetAsync((char*)d_ws + WS_CTL, 0, CTL_ZERO_BYTES, stream);
    Args a{};
    for (int i = 0; i < 27; ++i) a.in[i] = (const float*)d_in[i];
    a.out = (float*)d_out; a.ws = (unsigned char*)d_ws;
    if (MK_N_LAUNCHES == 1) {
        a.ph_lo = 0; a.ph_hi = N_PHASES;
        hipLaunchKernelGGL(mk_fwd, dim3(grid), dim3(512), LDS_BYTES, stream, a);
    } else {
        for (int p = 0; p < N_PHASES; ++p) { a.ph_lo = p; a.ph_hi = p + 1; hipLaunchKernelGGL(mk_fwd, dim3(grid), dim3(512), LDS_BYTES, stream, a); }
    }
}
```

```cpp
#include <hip/hip_runtime.h>
#include <cstdio>
#include <cstdint>

#ifndef MK_N_LAUNCHES
#define MK_N_LAUNCHES 1
#endif

#ifndef PROBE_MASK
#define PROBE_MASK 0u
#endif
#ifndef PROBE_SUB
#define PROBE_SUB 0u
#endif
#define LAS __attribute__((address_space(3)))
#define GAS __attribute__((address_space(1)))
typedef unsigned short bf16;
typedef short bf16x8 __attribute__((ext_vector_type(8)));
typedef float f32x2 __attribute__((ext_vector_type(2)));
typedef float f32x4 __attribute__((ext_vector_type(4)));
typedef float f32x16 __attribute__((ext_vector_type(16)));
typedef unsigned u32x2 __attribute__((ext_vector_type(2)));
typedef unsigned u32x4 __attribute__((ext_vector_type(4)));
typedef __bf16 bf16x2_t __attribute__((ext_vector_type(2)));
typedef int i32x4 __attribute__((ext_vector_type(4)));

constexpr int DM = 2048;
constexpr int LP = 16384;
constexpr int NB = 128;
constexpr int MT = LP + NB;
constexpr int MP = 16640;
constexpr int INW = 4112;
constexpr int NPROJ = 4096;
constexpr int DFF = 5632;
constexpr int CONVD = 1536;
constexpr float EPS = 1e-6f;
constexpr float LOG2E = 1.4426950408889634f;
constexpr int C_Q = 0, C_K = 1024, C_V = 1280, C_Z = 1536, C_X = 2560, C_B = 3584, C_C = 3840;
constexpr size_t PSLAB = (size_t)16384 * 64;
constexpr size_t PBC0 = (size_t)3584 * 16384;
__host__ __device__ __forceinline__ size_t proj_q(int head) { return (size_t)head * PSLAB; }
__host__ __device__ __forceinline__ size_t proj_k(int kvh) { return (size_t)(16 + kvh) * PSLAB; }
__host__ __device__ __forceinline__ size_t proj_v(int kvh) { return (size_t)(20 + kvh) * PSLAB; }
__host__ __device__ __forceinline__ size_t proj_z(int h) { return (size_t)(24 + h) * PSLAB; }
__host__ __device__ __forceinline__ size_t proj_x(int h) { return (size_t)(40 + h) * PSLAB; }
__host__ __device__ __forceinline__ size_t proj_b(int g) { return PBC0 + (size_t)g * 2 * PSLAB; }
__host__ __device__ __forceinline__ size_t proj_c(int g) { return PBC0 + (size_t)(2 + g) * 2 * PSLAB; }
constexpr size_t O_Y = 0, O_KP = 33816576, O_VP = 33849344, O_CP = 33882112, O_HP = 33886720, O_KS = 34017792, O_VS = 38212096, O_CS = 42406400, O_HS = 42996224;

constexpr size_t MiB = 1u << 20;
constexpr size_t WS_CTL = 0, CTL_ZERO_BYTES = 1 * MiB;
constexpr size_t WS_DT = 1 * MiB;
constexpr size_t WS_SSQA = WS_DT + (size_t)MT * 16 * 4;
constexpr size_t WS_SSQS = WS_SSQA + (size_t)MT * 16 * 4;
constexpr size_t WS_SSQ2 = WS_SSQS + (size_t)MT * 16 * 4;
constexpr size_t WS_SSQ2S = WS_SSQ2 + (size_t)LP * 32 * 4;
constexpr size_t WS_SSQ4 = WS_SSQ2S + 65536;
constexpr size_t WS_SSQ4S = WS_SSQ4 + (size_t)LP * 32 * 4;
constexpr size_t WS_DECAY = WS_SSQ4S + 65536;
constexpr size_t WS_WDT = WS_DECAY + 8192;
static_assert(WS_WDT + 131072 <= 8 * MiB + 524288, "small arrays");
constexpr size_t WS_MODF = 8 * MiB + 524288;
constexpr size_t WS_TAIL = 12 * MiB + 786432;
static_assert(WS_MODF + (size_t)129 * 8192 * 4 <= WS_TAIL && WS_TAIL + (size_t)256 * 4096 * 4 <= 17 * MiB, "ws head");
constexpr size_t WS_MODP = 17 * MiB;
constexpr size_t WS_WIN = 66 * MiB;
constexpr size_t WS_WOUT = 82 * MiB;
constexpr size_t WS_WGU = 90 * MiB;
constexpr size_t WS_WD = 134 * MiB;
constexpr size_t WS_U = 156 * MiB;
constexpr size_t WS_F = 333 * MiB;
constexpr size_t WS_U8 = 156 * MiB;
constexpr size_t WS_WGU8 = 90 * MiB;
constexpr size_t WS_ASC = 512 * 1024;
constexpr size_t WS_WSC = 640 * 1024;
constexpr size_t WS_ASC1 = 896 * 1024;
constexpr size_t WS_WSC1 = 976 * 1024;
constexpr size_t WS_U18 = 351 * MiB;
constexpr size_t WS_WIN8 = 416 * MiB;
constexpr size_t WS_MIX8 = 156 * MiB;
constexpr size_t WS_WOUT8 = 448 * MiB;
constexpr size_t WS_MSC = 896 * 1024;
constexpr size_t WS_WSC2 = 992 * 1024;
constexpr size_t WS_HSC = 704 * 1024;
constexpr size_t WS_WSCD = 832 * 1024;
constexpr size_t WS_WD8 = 66 * MiB;
constexpr size_t WS_H8 = 90 * MiB;
static_assert(WS_H8 + (size_t)MT * DFF <= 189 * MiB && WS_WD8 + (size_t)DM * DFF <= 90 * MiB && WS_WGU8 + (size_t)2 * DFF * DM <= 134 * MiB, "int8 overlays");
constexpr size_t WS_PROJ = 221 * MiB;
constexpr size_t WS_X1 = 221 * MiB;
constexpr size_t WS_MIXOUT = 286 * MiB;
constexpr size_t WS_H = 333 * MiB;
constexpr size_t WS_MIX = 351 * MiB;
constexpr size_t WS_STATES = 416 * MiB;
constexpr size_t WS_HPREV = 480 * MiB;
constexpr size_t WS_END = 512 * MiB;
static_assert(WS_H + (size_t)MT * DFF * 2 <= WS_END && WS_MIXOUT + (size_t)MT * DM * 2 <= WS_MIX && WS_X1 + (size_t)MT * DM * 2 <= WS_MIXOUT && WS_PROJ + (size_t)MT * NPROJ * 2 <= WS_MIX && WS_MODP + (size_t)8 * 129 * 12288 * 4 <= WS_WIN, "ws map");
constexpr int CW_BAR = 4096;

constexpr int RING_BYTES = 131072;
constexpr int TBL_OFF = RING_BYTES;
constexpr int P1PRM_OFF = RING_BYTES;
constexpr int LDSCTL_OFF = RING_BYTES + 16384, MISC_OFF = LDSCTL_OFF + 320;
constexpr int LDS_BYTES = 147456 + 512;

#define LDS_WAIT() asm volatile("s_waitcnt lgkmcnt(0)" ::: "memory")
#define VM_WAIT() asm volatile("s_waitcnt vmcnt(0)" ::: "memory")
__device__ __forceinline__ unsigned cvtpk(float lo, float hi) { f32x2 v = {lo, hi}; bf16x2_t b = __builtin_convertvector(v, bf16x2_t); return __builtin_bit_cast(unsigned, b); }
__device__ __forceinline__ unsigned pack_i8(float a, float b, float c, float d) {
    const int ia = (int)__builtin_rintf(fminf(fmaxf(a, -127.f), 127.f)), ib = (int)__builtin_rintf(fminf(fmaxf(b, -127.f), 127.f));
    const int ic = (int)__builtin_rintf(fminf(fmaxf(c, -127.f), 127.f)), id = (int)__builtin_rintf(fminf(fmaxf(d, -127.f), 127.f));
    return (unsigned)(ia & 255) | ((unsigned)(ib & 255) << 8) | ((unsigned)(ic & 255) << 16) | ((unsigned)(id & 255) << 24);
}
__device__ __forceinline__ float bflo(unsigned u) { return __uint_as_float(u << 16); }
__device__ __forceinline__ float bfhi(unsigned u) { return __uint_as_float(u & 0xffff0000u); }
__device__ __forceinline__ float silu_f(float x) { return x * __builtin_amdgcn_rcpf(1.f + __expf(-x)); }
__device__ __forceinline__ float wave_sum(float v) {
#pragma unroll
    for (int o = 1; o < 64; o <<= 1) v += __shfl_xor(v, o);
    return v;
}
__device__ __forceinline__ float wave_max(float v) {
#pragma unroll
    for (int o = 1; o < 64; o <<= 1) v = fmaxf(v, __shfl_xor(v, o));
    return v;
}

namespace pg8 {
typedef unsigned short bf16_t;
constexpr int BM = 256, BK = 64, HALF = 128, HTB = HALF * BK * 2, STAGE_BYTES = 8 * HTB, NXCD = 8, WGM = 8;
__host__ __device__ __forceinline__ int lds_byte(int r, int c) { const int st = (r >> 4) * 2 + (c >> 5), rr = r & 15, cc = c & 31, ob = rr * 64 + cc * 2; return st * 1024 + (ob ^ (((ob >> 9) & 1) << 5)); }
__host__ __device__ __forceinline__ void stage_rc(int b, int& R, int& C) { const int st = b / 1024, sb = b % 1024, swz = sb ^ (((sb >> 9) & 1) << 5); R = (st >> 1) * 16 + swz / 64; C = (st & 1) * 32 + (swz % 64) / 2; }
__host__ __device__ __forceinline__ int perm32(int rho) { const int n = rho >> 4, i = rho & 15; return 8 * (i >> 2) + 4 * n + (i & 3); }
struct Unit { int pm, pn; };
struct Gemm { const bf16_t* A; const bf16_t* Bt; int M, N, K; unsigned long long nmap; };
struct StaticOrder {
    int nM, nN, nwg, G, c, wgm;
    __host__ __device__ void init(int M, int N, int G_, int c_, int wgm_ = WGM) { nM = M / BM; nN = N / BM; nwg = nM * nN; G = G_; c = c_; wgm = wgm_; }
    __host__ __device__ bool next(int i, Unit& u) const {
        const long L = (long)i * G + c; if (L >= nwg) return false;
        int wgid = (int)L; { const int q = nwg / NXCD, r = nwg % NXCD, xcd = wgid % NXCD, off = wgid / NXCD; wgid = (xcd < r ? xcd * (q + 1) : r * (q + 1) + (xcd - r) * q) + off; }
        const int nig = wgm * nN, gid = wgid / nig, fm = gid * wgm, gsz = (nM - fm) < wgm ? (nM - fm) : wgm;
        u.pm = fm + ((wgid % nig) % gsz); u.pn = (wgid % nig) / gsz; return true;
    }
};


template <bool I8_>
struct EpiProj {
    static constexpr bool MID = false; static constexpr int PBIT = I8_ ? 19 : 20;
    bf16_t* O; int ldc; float* tail; const float* asc; const float* wsc;
    __device__ __forceinline__ void begin(const Unit& u, int ui, LAS unsigned char* lds) const {
        if (I8_) { const int tid = threadIdx.x; ((LAS float*)(lds + TBL_OFF))[(ui & 1) * 512 + tid] = (tid < 256) ? asc[u.pm * BM + tid] : wsc[u.pn * BM + (tid - 256)]; }
    }
    __device__ __forceinline__ void mid(f32x4 (&)[2][2][4][2], int, int, int, LAS unsigned char*) const {}
    __device__ __forceinline__ void operator()(const f32x4 (&acc)[2][2][4][2], const Unit& u, int ui, int wr, int wc, int fr, int fq, LAS unsigned char* lds) const {
        const int row0 = u.pm * BM + wr * 64 + fr, col0 = u.pn * BM + wc * 32 + 8 * fq;
        const LAS float* T = (const LAS float*)(lds + TBL_OFF) + (ui & 1) * 512;
#pragma unroll
        for (int ai = 0; ai < 2; ++ai)
#pragma unroll
            for (int m = 0; m < 4; ++m) {
                const int row = row0 + ai * HALF + m * 16;
#pragma unroll
                for (int bj = 0; bj < 2; ++bj) {
                    const int col = col0 + bj * HALF;
                    f32x4 v0, v1;
                    if (I8_) { const float sa = T[wr * 64 + fr + ai * HALF + m * 16]; const LAS f32x4* wt = (const LAS f32x4*)(T + 256 + wc * 32 + 8 * fq + bj * HALF); const f32x4 w0 = wt[0], w1 = wt[1];
                      const i32x4 i0 = __builtin_bit_cast(i32x4, acc[ai][bj][m][0]), i1 = __builtin_bit_cast(i32x4, acc[ai][bj][m][1]);
#pragma unroll
                      for (int j = 0; j < 4; ++j) { v0[j] = (float)i0[j] * (sa * w0[j]); v1[j] = (float)i1[j] * (sa * w1[j]); } }
                    else { v0 = acc[ai][bj][m][0]; v1 = acc[ai][bj][m][1]; }
                    u32x4 w; w.x = cvtpk(v0[0], v0[1]); w.y = cvtpk(v0[2], v0[3]); w.z = cvtpk(v1[0], v1[1]); w.w = cvtpk(v1[2], v1[3]);
                    bf16_t* dst = (col < 3584) ? O + (size_t)(col >> 6) * PSLAB + (size_t)row * 64 + (col & 63)
                                               : O + PBC0 + (size_t)((col - 3584) >> 7) * 2 * PSLAB + (size_t)row * 128 + (col & 127);
                    *(u32x4*)dst = w;
                    if (u.pm == 63 && ai == 1) { float* tp = tail + (size_t)(row - (LP - 128)) * NPROJ + col0 + bj * HALF; *(f32x4*)tp = v0; *(f32x4*)(tp + 4) = v1; }
                }
            }
    }
};
struct EpiSwiGLU {
    static constexpr bool MID = false; static constexpr int PBIT = 16;
    bf16_t* O; int ldc; const float* asc; const float* wsc;
    __device__ __forceinline__ void begin(const Unit& u, int ui, LAS unsigned char* lds) const {
        const int tid = threadIdx.x; ((LAS float*)(lds + TBL_OFF))[(ui & 1) * 512 + tid] = (tid < 256) ? asc[u.pm * BM + tid] : wsc[u.pn * BM + (tid - 256)];
    }
    __device__ __forceinline__ void mid(f32x4 (&)[2][2][4][2], int, int, int, LAS unsigned char*) const {}
    __device__ __forceinline__ void operator()(const f32x4 (&acc)[2][2][4][2], const Unit& u, int ui, int wr, int wc, int fr, int fq, LAS unsigned char* lds) const {
        const int row0 = u.pm * BM + wr * 64 + fr, col0 = u.pn * HALF + wc * 32 + 8 * fq;
        const LAS float* T = (const LAS float*)(lds + TBL_OFF) + (ui & 1) * 512;
#pragma unroll
        for (int ai = 0; ai < 2; ++ai)
#pragma unroll
            for (int m = 0; m < 4; ++m) {
                bf16_t* rowp = O + (size_t)(row0 + ai * HALF + m * 16) * ldc + col0;
                const float sa = T[wr * 64 + fr + ai * HALF + m * 16];
                float h[8];
#pragma unroll
                for (int n = 0; n < 2; ++n) {
                    const int wt0 = 256 + wc * 32 + 8 * fq + 4 * n;
                    const f32x4 sg = *(const LAS f32x4*)(T + wt0), su = *(const LAS f32x4*)(T + wt0 + HALF);
                    const i32x4 gi = __builtin_bit_cast(i32x4, acc[ai][0][m][n]), ui = __builtin_bit_cast(i32x4, acc[ai][1][m][n]);
#pragma unroll
                    for (int j = 0; j < 4; ++j) { const float g = (float)gi[j] * (sa * sg[j]), up = (float)ui[j] * (sa * su[j]); h[n * 4 + j] = silu_f(g) * up; }
                }
                u32x4 w; w.x = cvtpk(h[0], h[1]); w.y = cvtpk(h[2], h[3]); w.z = cvtpk(h[4], h[5]); w.w = cvtpk(h[6], h[7]);
                *(u32x4*)rowp = w;
            }
    }
};
template <bool MID_, bool I8_ = false>
struct EpiRowSsq {
    static constexpr bool MID = MID_; static constexpr int PBIT = I8_ ? 17 : 18;
    bf16_t* O; int ldc; float* ssq; const float* ssqa; const float* ssqs; const float* asc; const float* wsc;
    __device__ __forceinline__ void begin(const Unit& u, int ui, LAS unsigned char* lds) const {
        if (I8_) { const int tid = threadIdx.x; ((LAS float*)(lds + TBL_OFF))[(ui & 1) * 512 + tid] = (tid < 256) ? asc[u.pm * BM + tid] : wsc[u.pn * BM + (tid - 256)]; }
        if (MID_) {
            const int tid = threadIdx.x;
            if (tid < 256) {
                const int row = u.pm * BM + tid;
                const f32x4* pa = (const f32x4*)(ssqa + (size_t)row * 16); const f32x4* ps = (const f32x4*)(ssqs + (size_t)row * 16);
                float sa = 0.f, ss = 0.f;
#pragma unroll
                for (int i = 0; i < 4; ++i) { const f32x4 a = pa[i], s = ps[i]; sa += (a[0] + a[1]) + (a[2] + a[3]); ss += (s[0] + s[1]) + (s[2] + s[3]); }
                const float ra = 1.0f / sqrtf(sa * (1.0f / 1024.0f) + EPS), rs = 1.0f / sqrtf(ss * (1.0f / 1024.0f) + EPS);
                LAS f32x2* T = (LAS f32x2*)(lds + TBL_OFF) + (ui & 1) * 256;
                T[tid] = (f32x2){ra / rs, rs};
            }
        }
    }
    __device__ __forceinline__ void mid(f32x4 (&acc)[2][2][4][2], int ui, int wr, int fr, LAS unsigned char* lds) const {
        if (MID_) {
            const LAS f32x2* T = (const LAS f32x2*)(lds + TBL_OFF) + (ui & 1) * 256;
#pragma unroll
            for (int ai = 0; ai < 2; ++ai)
#pragma unroll
                for (int m = 0; m < 4; ++m) { const float r = T[ai * HALF + wr * 64 + m * 16 + fr].x;
#pragma unroll
                    for (int bj = 0; bj < 2; ++bj)
#pragma unroll
                        for (int n = 0; n < 2; ++n) acc[ai][bj][m][n] = acc[ai][bj][m][n] * r; }
        }
    }
    __device__ __forceinline__ void operator()(const f32x4 (&acc)[2][2][4][2], const Unit& u, int ui, int wr, int wc, int fr, int fq, LAS unsigned char* lds) const {
        const LAS f32x2* T = (const LAS f32x2*)(lds + TBL_OFF) + (ui & 1) * 256;
        const int col0 = u.pn * BM + wc * 32 + 8 * fq;
#pragma unroll
        for (int ai = 0; ai < 2; ++ai)
#pragma unroll
            for (int m = 0; m < 4; ++m) {
                const int rt = ai * HALF + wr * 64 + m * 16 + fr, row = u.pm * BM + rt;
                float sc = 1.f; if (MID_) sc = T[rt].y;
                bf16_t* rowp = O + (size_t)row * ldc + col0; float q = 0.f;
#pragma unroll
                for (int bj = 0; bj < 2; ++bj) {
                    f32x4 v0, v1;
                    if (I8_) { const LAS float* TI = (const LAS float*)(lds + TBL_OFF) + (ui & 1) * 512; const float sa = TI[rt]; const LAS f32x4* wt = (const LAS f32x4*)(TI + 256 + wc * 32 + 8 * fq + bj * HALF); const f32x4 w0 = wt[0], w1 = wt[1];
                        const i32x4 i0 = __builtin_bit_cast(i32x4, acc[ai][bj][m][0]), i1 = __builtin_bit_cast(i32x4, acc[ai][bj][m][1]);
#pragma unroll
                        for (int j = 0; j < 4; ++j) { v0[j] = (float)i0[j] * (sa * w0[j]); v1[j] = (float)i1[j] * (sa * w1[j]); } }
                    else { v0 = acc[ai][bj][m][0] * sc; v1 = acc[ai][bj][m][1] * sc; }
                    q += (v0[0] * v0[0] + v0[1] * v0[1]) + (v0[2] * v0[2] + v0[3] * v0[3]) + (v1[0] * v1[0] + v1[1] * v1[1]) + (v1[2] * v1[2] + v1[3] * v1[3]);
                    u32x4 w; w.x = cvtpk(v0[0], v0[1]); w.y = cvtpk(v0[2], v0[3]); w.z = cvtpk(v1[0], v1[1]); w.w = cvtpk(v1[2], v1[3]);
                    *(u32x4*)(rowp + bj * HALF) = w;
                }
                q += __shfl_xor(q, 16); q += __shfl_xor(q, 32);
                if (fq == 0) ssq[(size_t)row * 32 + u.pn * 4 + wc] = q;
            }
    }
};

template <class Epi, bool ALIGN_EPI = true, bool I8 = false>
__device__ __forceinline__ void gemm_phase(LAS unsigned char* lds, const Gemm g, const StaticOrder& S, const Epi& E) {
    const int tid = threadIdx.x, wid = __builtin_amdgcn_readfirstlane(tid >> 6), lane = tid & 63, wr = wid >> 2, wc = wid & 3, fr = lane & 15, fq = lane >> 4;
    const int K = g.K, nt = K / BK;
    unsigned voffA[2], voffB[2];
#pragma unroll
    for (int i = 0; i < 2; ++i) { int R, C; stage_rc(tid * 16 + i * 8192, R, C); const int Rb = (R & ~31) + perm32(R & 31);
        voffA[i] = (unsigned)(R * K + C) * 2u; voffB[i] = (unsigned)(Rb * K + C) * 2u; }
    const size_t kstep = (size_t)(BK * 2);
    const size_t hstep = (size_t)HALF * K * 2;
    const size_t tstep = 2 * hstep;
    const unsigned ldsw = (unsigned)wid * 1024u;
    const int aoff = lds_byte(wr * 64 + fr, fq * 8), boff = lds_byte(wc * 32 + fr, fq * 8);
#define PG8_SA(b, h) (((b) * 2 + (h)) * HTB)
#define PG8_SB(b, h) ((4 + (b) * 2 + (h)) * HTB)
#define PG8_STAGE(bufoff, gbase, voff) do { _Pragma("unroll") for (int _i = 0; _i < 2; ++_i) \
        __builtin_amdgcn_global_load_lds((const unsigned*)((const char*)(gbase) + (voff)[_i]), (LAS unsigned*)(lds + (bufoff) + ldsw + _i * 8192), 16, 0, 0); } while (0)
#define PG8_LDA(dst, b, h) do { _Pragma("unroll") for (int m = 0; m < 4; ++m) _Pragma("unroll") for (int k = 0; k < 2; ++k) dst[m][k] = *(const LAS bf16x8*)(lds + PG8_SA(b, h) + aoff + m * 2048 + k * 1024); } while (0)
#define PG8_LDB(dst, b, h) do { _Pragma("unroll") for (int n = 0; n < 2; ++n) _Pragma("unroll") for (int k = 0; k < 2; ++k) dst[n][k] = *(const LAS bf16x8*)(lds + PG8_SB(b, h) + boff + n * 2048 + k * 1024); } while (0)
#define PG8_MMA(ai, bj, At, Bt) do { __builtin_amdgcn_s_setprio(1); _Pragma("unroll") for (int m = 0; m < 4; ++m) _Pragma("unroll") for (int n = 0; n < 2; ++n) _Pragma("unroll") for (int k = 0; k < 2; ++k) \
        { if constexpr (I8) acc[ai][bj][m][n] = __builtin_bit_cast(f32x4, __builtin_amdgcn_mfma_i32_16x16x64_i8(__builtin_bit_cast(i32x4, Bt[n][k]), __builtin_bit_cast(i32x4, At[m][k]), __builtin_bit_cast(i32x4, acc[ai][bj][m][n]), 0, 0, 0)); \
          else acc[ai][bj][m][n] = __builtin_amdgcn_mfma_f32_16x16x32_bf16(Bt[n][k], At[m][k], acc[ai][bj][m][n], 0, 0, 0); } __builtin_amdgcn_s_setprio(0); } while (0)
#define PG8_WAIT_V(n) asm volatile("s_waitcnt vmcnt(" #n ")" ::: "memory")
#define PG8_WAIT_L(n) asm volatile("s_waitcnt lgkmcnt(" #n ")" ::: "memory")
#define PG8_BAR __builtin_amdgcn_s_barrier()
#define PG8_SCHED __builtin_amdgcn_sched_barrier(0)
    Unit cur, nxt; int ui = 0;
    if (!S.next(0, cur)) return;
    f32x4 acc[2][2][4][2];
#pragma unroll
    for (int a = 0; a < 2; ++a)
#pragma unroll
        for (int b = 0; b < 2; ++b)
#pragma unroll
            for (int m = 0; m < 4; ++m)
#pragma unroll
                for (int n = 0; n < 2; ++n) acc[a][b][m][n] = (f32x4){0.f, 0.f, 0.f, 0.f};
    bf16x8 At[4][2], B0[2][2], B1[2][2];
    const unsigned long long nmap = g.nmap;
#define PG8_PN(u_) (nmap ? (int)((nmap >> (4 * (u_).pn)) & 15ull) : (u_).pn)
    cur.pn = PG8_PN(cur);
    const char* cA = (const char*)g.A + (size_t)cur.pm * tstep; const char* cB = (const char*)g.Bt + (size_t)cur.pn * tstep;
    E.begin(cur, 0, lds);
    PG8_STAGE(PG8_SB(0, 0), cB, voffB); PG8_STAGE(PG8_SB(0, 1), cB + hstep, voffB); PG8_STAGE(PG8_SA(0, 0), cA, voffA); PG8_STAGE(PG8_SA(0, 1), cA + hstep, voffA);
    if (wr == 1) PG8_BAR;
    PG8_WAIT_V(2); PG8_BAR;
    PG8_STAGE(PG8_SB(1, 0), cB + kstep, voffB); PG8_STAGE(PG8_SA(1, 0), cA + kstep, voffA); PG8_STAGE(PG8_SB(1, 1), cB + hstep + kstep, voffB);
    PG8_WAIT_V(6); PG8_BAR;
    for (;;) {
        const bool has_next = S.next(ui + 1, nxt); if (has_next) nxt.pn = PG8_PN(nxt);
        const char* nA = has_next ? (const char*)g.A + (size_t)nxt.pm * tstep : cA; const char* nB = has_next ? (const char*)g.Bt + (size_t)nxt.pn * tstep : cB;
        for (int t = 0; t < nt; t += 2) {
            const bool last = (t == nt - 2);
            const char* a1 = cA + (size_t)(t + 1) * kstep;
            const char* a2 = last ? nA : cA + (size_t)(t + 2) * kstep; const char* b2 = last ? nB : cB + (size_t)(t + 2) * kstep;
            const char* a3 = a2 + kstep; const char* b3 = b2 + kstep;
            if constexpr (Epi::MID) { if (t == (nt >> 1)) E.mid(acc, ui, wr, fr, lds); }
            PG8_LDB(B0, 0, 0); PG8_LDB(B1, 0, 1); PG8_SCHED; PG8_LDA(At, 0, 0); PG8_STAGE(PG8_SA(1, 1), a1 + hstep, voffA);
            PG8_WAIT_V(8); PG8_WAIT_L(0); PG8_BAR; PG8_MMA(0, 0, At, B0); PG8_MMA(0, 1, At, B1); PG8_BAR; PG8_SCHED;
            PG8_LDA(At, 0, 1); PG8_STAGE(PG8_SB(0, 0), b2, voffB); PG8_STAGE(PG8_SB(0, 1), b2 + hstep, voffB); PG8_STAGE(PG8_SA(0, 0), a2, voffA);
            PG8_WAIT_V(8); PG8_WAIT_L(0); PG8_BAR; PG8_MMA(1, 0, At, B0); PG8_MMA(1, 1, At, B1); PG8_BAR; PG8_SCHED;
            PG8_LDB(B0, 1, 0); PG8_LDB(B1, 1, 1); PG8_SCHED; PG8_LDA(At, 1, 0); PG8_STAGE(PG8_SA(0, 1), a2 + hstep, voffA);
            PG8_WAIT_V(8); PG8_WAIT_L(0); PG8_BAR; PG8_MMA(0, 0, At, B0); PG8_MMA(0, 1, At, B1); PG8_BAR; PG8_SCHED;
            PG8_LDA(At, 1, 1); PG8_STAGE(PG8_SB(1, 0), b3, voffB); PG8_STAGE(PG8_SB(1, 1), b3 + hstep, voffB); PG8_STAGE(PG8_SA(1, 0), a3, voffA);
            PG8_WAIT_V(8); PG8_WAIT_L(0); PG8_BAR; PG8_MMA(1, 0, At, B0); PG8_MMA(1, 1, At, B1); PG8_BAR; PG8_SCHED;
        }
        if constexpr (ALIGN_EPI) { if (wr == 0) PG8_BAR; }
        E(acc, cur, ui, wr, wc, fr, fq, lds);
        if constexpr ((PROBE_SUB >> Epi::PBIT) & 1u) { PG8_SCHED; E(acc, cur, ui, wr, wc, fr, fq, lds); }
        if (!has_next) break;
#pragma unroll
        for (int a = 0; a < 2; ++a)
#pragma unroll
            for (int b = 0; b < 2; ++b)
#pragma unroll
                for (int m = 0; m < 4; ++m)
#pragma unroll
                    for (int n = 0; n < 2; ++n) acc[a][b][m][n] = (f32x4){0.f, 0.f, 0.f, 0.f};
        cur = nxt; cA = nA; cB = nB; ++ui;
        E.begin(cur, ui, lds);
        if constexpr (ALIGN_EPI) { if (wr == 1) PG8_BAR; }
    }
    PG8_WAIT_V(0);
    if constexpr (!ALIGN_EPI) { if (wr == 0) PG8_BAR; }
    PG8_BAR;
#undef PG8_PN
#undef PG8_SA
#undef PG8_SB
#undef PG8_STAGE
#undef PG8_LDA
#undef PG8_LDB
#undef PG8_MMA
#undef PG8_WAIT_V
#undef PG8_WAIT_L
#undef PG8_BAR
#undef PG8_SCHED
}
}

#define RLX_AGENT __ATOMIC_RELAXED, __HIP_MEMORY_SCOPE_AGENT
#define XB_TMO      128
#define XB_XCNT(j)  (256  + 64 * (j))
#define XB_XSUB(j)  (1280 + 64 * (j))
#define XB_XGEN(j)  (2304 + 64 * (j))
#define XB_TOP      3328
#define XB_TOPGEN   3392
#define XCD_BAR_WORDS 3456
#define XB_SPIN_CAP (1u << 22)
__device__ __forceinline__ unsigned xb_ld(unsigned* p)              { return __hip_atomic_load(p, __ATOMIC_RELAXED, __HIP_MEMORY_SCOPE_AGENT); }
__device__ __forceinline__ unsigned xb_add(unsigned* p, unsigned v) { return __hip_atomic_fetch_add(p, v, __ATOMIC_RELAXED, __HIP_MEMORY_SCOPE_AGENT); }
__device__ __forceinline__ unsigned xb_xcc_id() { return (unsigned)__builtin_amdgcn_s_getreg((3 << 11) | 20) & 0xFu; }
#define XB_SPIN(cond, bar) do { unsigned _sp = 0; while (cond) { __builtin_amdgcn_s_sleep(1); \
    if ((++_sp & 255u) == 0u) { if (xb_ld(&(bar)[XB_TMO])) break; if (_sp > XB_SPIN_CAP) { atomicAdd(&(bar)[XB_TMO], 1u); break; } } } } while (0)
struct XcdBarrier { unsigned* bar; unsigned x; volatile LAS unsigned* st; };
__device__ __forceinline__ XcdBarrier xcd_barrier_post(unsigned* bar, volatile LAS unsigned* st) {
    XcdBarrier b; b.bar = bar; b.x = xb_xcc_id(); b.st = st;
    if (threadIdx.x == 0) (void)xb_add(&bar[XB_XCNT(b.x)], 1u);
    return b;
}
__device__ __forceinline__ void xcd_barrier_complete(unsigned* bar, unsigned x, unsigned& nloc, unsigned& nx) {
    const unsigned G = gridDim.x * gridDim.y * gridDim.z;
    unsigned sum, cnt, mine, sp = 0u;
    for (;;) {
        sum = 0u; cnt = 0u; mine = 0u;
#pragma unroll
        for (unsigned j = 0; j < 16; ++j) { const unsigned c = xb_ld(&bar[XB_XCNT(j)]); sum += c; cnt += (c > 0u) ? 1u : 0u; mine = (j == x) ? c : mine; }
        if (sum == G) break;
        __builtin_amdgcn_s_sleep(1);
        if ((++sp & 255u) == 0u) { if (xb_ld(&bar[XB_TMO])) break; if (sp > XB_SPIN_CAP) { atomicAdd(&bar[XB_TMO], 1u); break; } }
    }
    nloc = mine > 0u ? mine : 1u; nx = cnt > 0u ? cnt : 1u;
}
__device__ __forceinline__ void xcd_barrier(const XcdBarrier& b) {
    asm volatile("s_waitcnt vmcnt(0)" ::: "memory");
    __syncthreads();
    if (threadIdx.x == 0) {
        unsigned* bar = b.bar;
        __builtin_amdgcn_s_waitcnt(0);
        unsigned nloc = b.st[0], nx = b.st[1];
        if (nloc == 0u) { xcd_barrier_complete(bar, b.x, nloc, nx); b.st[0] = nloc; b.st[1] = nx; }
        const unsigned old = xb_add(&bar[XB_XSUB(b.x)], 1u);
        const unsigned gen = old / nloc;
        if (old + 1u == (gen + 1u) * nloc) {
            __builtin_amdgcn_fence(__ATOMIC_RELEASE, "agent");
            asm volatile("s_waitcnt vmcnt(0)" ::: "memory");
            const unsigned og = xb_add(&bar[XB_TOP], 1u);
            const unsigned tg = og / nx;
            if (og + 1u == (tg + 1u) * nx) xb_add(&bar[XB_TOPGEN], 1u);
            else XB_SPIN(xb_ld(&bar[XB_TOPGEN]) == tg, bar);
            __builtin_amdgcn_fence(__ATOMIC_ACQUIRE, "agent");
            xb_add(&bar[XB_XGEN(b.x)], 1u);
            asm volatile("s_waitcnt vmcnt(0)" ::: "memory");
        } else {
            XB_SPIN(xb_ld(&bar[XB_XGEN(b.x)]) == gen, bar);
            __builtin_amdgcn_fence(__ATOMIC_ACQUIRE, "agent");
            asm volatile("s_waitcnt vmcnt(0)" ::: "memory");
        }
    }
    __syncthreads();
}

struct Frame {
    LAS unsigned char* lds;
    int tid, lane, wave, G, bid;
    const float *xp, *xs, *cache_k, *cache_v, *state_conv, *state_ssm, *c_prompt, *c_sample, *w_ada, *b_ada, *g_pre_mix, *g_post_mix, *w_in, *sinks, *g_att,
        *conv_w, *conv_b, *dt_bias, *a_log, *d_skip, *g_ssm, *w_out, *g_pre_ffn, *g_post_ffn, *w_gate, *w_up, *w_down;
    float* out;
    signed char *U8, *Wgu8, *H8, *Wd8, *Win8, *U18, *MIX8, *Wout8; float *ASC, *WSC, *HSC, *WSCD, *ASC1, *WSC1, *MSC, *WSC2;
    bf16 *X1, *WinT, *WoutT, *WguT, *WdT, *U, *PROJ, *MIX, *MIXOUT, *HB, *FB, *HPREV;
    float *MODP, *MODF, *DT, *SSQA, *SSQS, *SSQ2, *SSQ4, *SSQ2S, *SSQ4S, *TAIL, *DECAY, *WDT; bf16* STATES;
};

struct TrItem { const float* src; bf16* dst; int ldw, ldt; };
constexpr int TI_IN = 4096, TI_OUT = 2048, TI_G = 5632, TI_U = 5632, TI_D = 5632;
__device__ __forceinline__ TrItem tr_decode(const Frame& F, int it) {
    TrItem t;
    if (it < TI_IN) { const int kb = it >> 7, nb = it & 127; t.src = F.w_in + (size_t)(64 * kb) * INW + 32 * nb; t.ldw = INW; t.dst = F.WinT + (size_t)(32 * nb) * DM + 64 * kb; t.ldt = DM; return t; } it -= TI_IN;
    if (it < TI_OUT) { const int kb = it >> 6, nb = it & 63; t.src = F.w_out + (size_t)(64 * kb) * DM + 32 * nb; t.ldw = DM; t.dst = F.WoutT + (size_t)(32 * nb) * DM + 64 * kb; t.ldt = DM; return t; } it -= TI_OUT;
    if (it < TI_G) { const int kb = it / 176, nb = it % 176, n0 = 32 * nb; t.src = F.w_gate + (size_t)(64 * kb) * DFF + n0; t.ldw = DFF; t.dst = F.WguT + (size_t)((n0 >> 7) * 256 + (n0 & 127)) * DM + 64 * kb; t.ldt = DM; return t; } it -= TI_G;
    if (it < TI_U) { const int kb = it / 176, nb = it % 176, n0 = 32 * nb; t.src = F.w_up + (size_t)(64 * kb) * DFF + n0; t.ldw = DFF; t.dst = F.WguT + (size_t)((n0 >> 7) * 256 + 128 + (n0 & 127)) * DM + 64 * kb; t.ldt = DM; return t; } it -= TI_U;
    { const int kb = it >> 6, nb = it & 63; t.src = F.w_down + (size_t)(64 * kb) * DM + 32 * nb; t.ldw = DM; t.dst = F.WdT + (size_t)(32 * nb) * DFF + 64 * kb; t.ldt = DFF; return t; }
}
__device__ __forceinline__ void tr_load(const TrItem& t, int lane, float (&tv)[32]) {
    const float* p = t.src + (size_t)(lane >> 5) * t.ldw + (lane & 31);
#pragma unroll
    for (int i = 0; i < 32; ++i) tv[i] = __builtin_nontemporal_load(p + (size_t)(2 * i) * t.ldw);
}
__device__ __forceinline__ void tr_store(const TrItem& t, int lane, const float (&tv)[32], LAS float* scr) {
#pragma unroll
    for (int i = 0; i < 32; ++i) { const int kk = 2 * i + (lane >> 5); scr[kk * 33 + (lane & 31)] = tv[i]; }
    LDS_WAIT(); asm volatile("" ::: "memory");
    const int c = lane & 7;
#pragma unroll
    for (int j = 0; j < 4; ++j) { const int n = (lane >> 3) + 8 * j; const LAS float* s = scr + (8 * c) * 33 + n;
        u32x4 o; o.x = cvtpk(s[0 * 33], s[1 * 33]); o.y = cvtpk(s[2 * 33], s[3 * 33]); o.z = cvtpk(s[4 * 33], s[5 * 33]); o.w = cvtpk(s[6 * 33], s[7 * 33]);
        *(u32x4*)(t.dst + (size_t)n * t.ldt + 8 * c) = o; }
    LDS_WAIT(); asm volatile("" ::: "memory");
}
__device__ __forceinline__ void transpose_range(Frame& F, int base, int first, int end, int step, LAS float* scr) {
    int it = first; if (it >= end) return;
    float ta[32], tb[32];
    TrItem ia = tr_decode(F, base + it), ib = ia;
    tr_load(ia, F.lane, ta);
#pragma unroll 1
    for (; it < end; it += 2 * step) {
        const int i1 = it + step, i2 = i1 + step;
        if (i1 < end) { ib = tr_decode(F, base + i1); tr_load(ib, F.lane, tb); }
        tr_store(ia, F.lane, ta, scr);
        if (i2 < end) { ia = tr_decode(F, base + i2); tr_load(ia, F.lane, ta); }
        if (i1 < end) tr_store(ib, F.lane, tb, scr);
    }
}
__device__ __forceinline__ void mod_kslab(Frame& F, int vb, int cs0, int ncs) {
    LAS unsigned char* lds = F.lds;
    const int tid = F.tid, lane = F.lane, w = F.wave, fr = lane & 15, fq = lane >> 4, nf = w & 3, kh = w >> 2;
    const int kslab = vb & 7, cgroup = vb >> 3, k0 = kslab * 256;
#pragma unroll 3
    for (int i = 0; i < 9; ++i) {
        const int id = tid + 512 * i, row = id >> 5, ch = id & 31;
        f32x4 a = (f32x4){0.f, 0.f, 0.f, 0.f}, b = a;
        if (row <= 128) { const float* src = (row < 128 ? F.c_sample + (size_t)row * DM : F.c_prompt) + k0 + 8 * ch; a = *(const f32x4*)src; b = *(const f32x4*)(src + 4); }
        u32x4 o; o.x = cvtpk(silu_f(a[0]), silu_f(a[1])); o.y = cvtpk(silu_f(a[2]), silu_f(a[3]));
        o.z = cvtpk(silu_f(b[0]), silu_f(b[1])); o.w = cvtpk(silu_f(b[2]), silu_f(b[3]));
        *(LAS u32x4*)(lds + row * 512 + ((ch ^ (row & 15)) * 16)) = o;
    }
    __syncthreads();
    LAS unsigned char* tile = lds + 73728 + w * 2048;
    LAS f32x4* red = (LAS f32x4*)(lds + 90112);
    float* outp = F.MODP + (size_t)kslab * 129 * 12288;
    const float* wbase = F.w_ada + (size_t)(k0 + kh * 128 + (lane >> 2)) * 12288 + (lane & 3) * 4 + 16 * nf;
    f32x4 wv[4][2], wn[4][2];
    const int csb = cs0 + cgroup * ncs;
    { const float* wp = wbase + csb * 64;
#pragma unroll
      for (int sx = 0; sx < 4; ++sx) { wn[sx][0] = __builtin_nontemporal_load((const f32x4*)(wp + (size_t)(32 * sx) * 12288)); wn[sx][1] = __builtin_nontemporal_load((const f32x4*)(wp + (size_t)(32 * sx + 16) * 12288)); } }
#pragma unroll 1
    for (int u = 0; u < ncs; ++u) {
        const int n0 = (csb + u) * 64 + 16 * nf;
#pragma unroll
        for (int sx = 0; sx < 4; ++sx) { wv[sx][0] = wn[sx][0]; wv[sx][1] = wn[sx][1]; }
        if (u + 1 < ncs) { const float* wp = wbase + (csb + u + 1) * 64;
#pragma unroll
            for (int sx = 0; sx < 4; ++sx) { wn[sx][0] = __builtin_nontemporal_load((const f32x4*)(wp + (size_t)(32 * sx) * 12288)); wn[sx][1] = __builtin_nontemporal_load((const f32x4*)(wp + (size_t)(32 * sx + 16) * 12288)); } }
        f32x4 acc[9];
#pragma unroll
        for (int i = 0; i < 9; ++i) acc[i] = (f32x4){0.f, 0.f, 0.f, 0.f};
#pragma unroll
        for (int sp = 0; sp < 2; ++sp) {
#pragma unroll
            for (int t = 0; t < 2; ++t) { const int sx = 2 * sp + t; LAS unsigned char* tb = tile + t * 1024;
                *(LAS u32x2*)(tb + (lane >> 2) * 32 + (lane & 3) * 8) = (u32x2){cvtpk(wv[sx][0][0], wv[sx][0][1]), cvtpk(wv[sx][0][2], wv[sx][0][3])};
                *(LAS u32x2*)(tb + (16 + (lane >> 2)) * 32 + (lane & 3) * 8) = (u32x2){cvtpk(wv[sx][1][0], wv[sx][1][1]), cvtpk(wv[sx][1][2], wv[sx][1][3])}; }
            bf16x8 af[2][9];
#pragma unroll
            for (int t = 0; t < 2; ++t) { const int chunk = kh * 16 + 4 * (2 * sp + t) + fq;
#pragma unroll
                for (int mf = 0; mf < 9; ++mf) af[t][mf] = *(const LAS bf16x8*)(lds + (16 * mf + fr) * 512 + ((chunk ^ fr) * 16)); }
            __builtin_amdgcn_sched_barrier(0);
            LDS_WAIT();
            unsigned e[2][8];
#pragma unroll
            for (int t = 0; t < 2; ++t)
#pragma unroll
                for (int j = 0; j < 8; ++j) e[t][j] = *(const LAS unsigned short*)(tile + t * 1024 + (8 * fq + j) * 32 + fr * 2);
            __builtin_amdgcn_sched_barrier(0);
            LDS_WAIT();
#pragma unroll
            for (int t = 0; t < 2; ++t) {
                const u32x4 bw = (u32x4){e[t][0] | (e[t][1] << 16), e[t][2] | (e[t][3] << 16), e[t][4] | (e[t][5] << 16), e[t][6] | (e[t][7] << 16)};
                const bf16x8 bfrag = __builtin_bit_cast(bf16x8, bw);
#pragma unroll
                for (int mf = 0; mf < 9; ++mf) acc[mf] = __builtin_amdgcn_mfma_f32_16x16x32_bf16(bfrag, af[t][mf], acc[mf], 0, 0, 0);
            }
            __builtin_amdgcn_sched_barrier(0);
        }
        if (kh == 1) {
#pragma unroll
            for (int mf = 0; mf < 9; ++mf) red[(nf * 9 + mf) * 64 + lane] = acc[mf];
        }
        __syncthreads();
        if (kh == 0) {
#pragma unroll
            for (int mf = 0; mf < 9; ++mf) { const int m = 16 * mf + fr; const f32x4 o = acc[mf] + red[(nf * 9 + mf) * 64 + lane];
                if (m < 129) *(f32x4*)(outp + (size_t)m * 12288 + n0 + 4 * fq) = o; }
        }
        __syncthreads();
    }
}
__device__ __forceinline__ f32x4 mod4(const Frame& F, int mrow, int idx4) {
    f32x4 s = ((const f32x4*)F.b_ada)[idx4];
    const f32x4* p = (const f32x4*)F.MODP + (size_t)mrow * 3072 + idx4;
#pragma unroll
    for (int k = 0; k < 8; ++k) s += p[(size_t)k * 129 * 3072];
    return s;
}
__device__ __forceinline__ void ph0(Frame& F) {
    const int gt = F.bid * 512 + F.tid, NT = F.G * 512;
    for (int i = gt; i < 16 * DM; i += NT) { const int h = i & 15, k = i >> 4; F.WDT[h * DM + k] = F.w_in[(size_t)k * INW + NPROJ + h]; }
    for (int vb = F.bid; vb < 256; vb += F.G) mod_kslab(F, vb, 0, 6);
    LAS float* scr = (LAS float*)(F.lds + F.wave * 16384);
    transpose_range(F, 0, F.bid * 8 + F.wave, TI_IN, F.G * 8, scr);
}
template <bool isout>
__device__ __forceinline__ void wgu_strip(Frame& F, int sid) {
    LAS unsigned char* lds = F.lds;
    const int tid = F.tid, lane = F.lane, w = F.wave;
    const int mtx = isout ? 0 : sid / 176, nb = isout ? sid : sid - mtx * 176, n0 = 32 * nb;
    constexpr int ldw = isout ? DM : DFF;
    const float* src = (isout ? F.w_out : (mtx ? F.w_up : F.w_gate)) + n0;
    const int r0 = isout ? n0 : (n0 >> 7) * 256 + mtx * 128 + (n0 & 127);
    signed char* dst8 = isout ? F.Wout8 : F.Wgu8; float* dsc = isout ? F.WSC2 : F.WSC;
    constexpr int S = 4104;
    const int c = tid & 7, kp = tid >> 3;
    float am[4] = {0.f, 0.f, 0.f, 0.f};
#pragma unroll 1
    for (int pass = 0; pass < 16; pass += 8) {
        f32x4 a[8][2];
#pragma unroll
        for (int q = 0; q < 8; ++q) { const float* p = src + (size_t)((pass + q) * 128 + 2 * kp) * ldw + 4 * c;
            a[q][0] = __builtin_nontemporal_load((const f32x4*)p); a[q][1] = __builtin_nontemporal_load((const f32x4*)(p + ldw)); }
#pragma unroll
        for (int q = 0; q < 8; ++q)
#pragma unroll
            for (int j = 0; j < 4; ++j) { const unsigned pk = cvtpk(a[q][0][j], a[q][1][j]);
                am[j] = fmaxf(am[j], fmaxf(fabsf(bflo(pk)), fabsf(bfhi(pk))));
                *(LAS unsigned*)(lds + (4 * c + j) * S + ((pass + q) * 64 + kp) * 4) = pk; }
    }
    LAS float* red = (LAS float*)(lds + 131584);
#pragma unroll
    for (int j = 0; j < 4; ++j) { am[j] = fmaxf(am[j], __shfl_xor(am[j], 8)); am[j] = fmaxf(am[j], __shfl_xor(am[j], 16)); am[j] = fmaxf(am[j], __shfl_xor(am[j], 32)); }
    if (lane < 8) {
#pragma unroll
        for (int j = 0; j < 4; ++j) red[w * 32 + 4 * lane + j] = am[j];
    }
    __syncthreads();
#pragma unroll 1
    for (int q = 0; q < 4; ++q) {
        const int n = 4 * w + q;
        float mx = red[n];
#pragma unroll
        for (int ww = 1; ww < 8; ++ww) mx = fmaxf(mx, red[ww * 32 + n]);
        mx = fmaxf(mx, 1e-30f);
        const float qs = 127.0f / mx;
        if (lane == 0) dsc[r0 + n] = mx * (1.0f / 127.0f);
        unsigned* dst = (unsigned*)(dst8 + (size_t)(r0 + n) * DM);
        u32x2 v[8];
#pragma unroll
        for (int i = 0; i < 8; ++i) v[i] = *(const LAS u32x2*)(lds + n * S + (i * 256 + lane * 4) * 2);
#pragma unroll
        for (int i = 0; i < 8; ++i) dst[i * 64 + lane] = pack_i8(bflo(v[i].x) * qs, bfhi(v[i].x) * qs, bflo(v[i].y) * qs, bfhi(v[i].y) * qs);
    }
    __syncthreads();
}
__device__ __forceinline__ void prep_late(Frame& F) {
    for (int sid = F.bid; sid < 416; sid += F.G) { if (sid < 352) wgu_strip<false>(F, sid); else wgu_strip<true>(F, sid - 352); }
    LAS float* scr = (LAS float*)(F.lds + F.wave * 16384);
    constexpr int TB = TI_IN + TI_OUT + TI_G + TI_U;
    if (F.G == 256) {
        if (F.bid < 160) transpose_range(F, TB, 10 * F.bid + F.wave, 10 * F.bid + 10, 8, scr);
        else transpose_range(F, TB, 1600 + (F.bid - 160) * 8 + F.wave, TI_D, 96 * 8, scr);
    } else transpose_range(F, TB, F.bid * 8 + F.wave, TI_D, F.G * 8, scr);
    __syncthreads();
}

template <int NCH>
__device__ __forceinline__ void quant_row(const bf16* src, signed char* dst, float* scale_out, int lane) {
    const u32x4* s4 = (const u32x4*)src; u32x4 v[NCH]; float amax = 0.f;
#pragma unroll
    for (int j = 0; j < NCH; ++j) { v[j] = __builtin_nontemporal_load(s4 + lane + 64 * j);
#pragma unroll
        for (int e = 0; e < 4; ++e) amax = fmaxf(amax, fmaxf(fabsf(bflo(v[j][e])), fabsf(bfhi(v[j][e])))); }
    amax = fmaxf(wave_max(amax), 1e-30f);
    const float qs = 127.0f / amax;
    if (lane == 0) *scale_out = amax * (1.0f / 127.0f);
    u32x2* d = (u32x2*)dst;
#pragma unroll
    for (int j = 0; j < NCH; ++j) d[lane + 64 * j] = (u32x2){pack_i8(bflo(v[j].x) * qs, bfhi(v[j].x) * qs, bflo(v[j].y) * qs, bfhi(v[j].y) * qs), pack_i8(bflo(v[j].z) * qs, bfhi(v[j].z) * qs, bflo(v[j].w) * qs, bfhi(v[j].w) * qs)};
}
template <int NCH>
__device__ __forceinline__ void quant_load(const bf16* src, int lane, u32x4 (&v)[NCH]) {
    const u32x4* s4 = (const u32x4*)src;
#pragma unroll
    for (int j = 0; j < NCH; ++j) v[j] = __builtin_nontemporal_load(s4 + lane + 64 * j);
}
template <int NCH>
__device__ __forceinline__ void quant_proc(const u32x4 (&v)[NCH], signed char* dst, float* scale_out, int lane) {
    float amax = 0.f;
#pragma unroll
    for (int j = 0; j < NCH; ++j)
#pragma unroll
        for (int e = 0; e < 4; ++e) amax = fmaxf(amax, fmaxf(fabsf(bflo(v[j][e])), fabsf(bfhi(v[j][e]))));
    amax = fmaxf(wave_max(amax), 1e-30f);
    const float qs = 127.0f / amax;
    if (lane == 0) *scale_out = amax * (1.0f / 127.0f);
    u32x2* d = (u32x2*)dst;
#pragma unroll
    for (int j = 0; j < NCH; ++j) d[lane + 64 * j] = (u32x2){pack_i8(bflo(v[j].x) * qs, bfhi(v[j].x) * qs, bflo(v[j].y) * qs, bfhi(v[j].y) * qs), pack_i8(bflo(v[j].z) * qs, bfhi(v[j].z) * qs, bflo(v[j].w) * qs, bfhi(v[j].w) * qs)};
}
__device__ __forceinline__ void row_load8(const float* p, int lane, f32x4 (&x)[8]) {
    const f32x4* xr = (const f32x4*)p;
#pragma unroll
    for (int j = 0; j < 8; ++j) x[j] = __builtin_nontemporal_load(xr + lane + 64 * j);
}
__device__ __forceinline__ float dot2bf(unsigned a, unsigned b, float c) { return __builtin_amdgcn_fdot2_f32_bf16(__builtin_bit_cast(bf16x2_t, a), __builtin_bit_cast(bf16x2_t, b), c, false); }
__device__ __forceinline__ void dt_from_row(const Frame& F, int r, const u32x2 (&pk)[8], const LAS u32x4* W2) {
    const int lane = F.lane;
    float p[16];
#pragma unroll
    for (int h = 0; h < 16; ++h) p[h] = 0.f;
#pragma unroll
    for (int jj = 0; jj < 4; ++jj) {
#pragma unroll
        for (int hg = 0; hg < 2; ++hg) {
            u32x4 w[8];
#pragma unroll
            for (int i = 0; i < 8; ++i) w[i] = W2[(hg * 8 + i) * 256 + lane + 64 * jj];
#pragma unroll
            for (int i = 0; i < 8; ++i) p[hg * 8 + i] = dot2bf(pk[2 * jj].x, w[i].x, p[hg * 8 + i]);
#pragma unroll
            for (int i = 0; i < 8; ++i) p[hg * 8 + i] = dot2bf(pk[2 * jj].y, w[i].y, p[hg * 8 + i]);
#pragma unroll
            for (int i = 0; i < 8; ++i) p[hg * 8 + i] = dot2bf(pk[2 * jj + 1].x, w[i].z, p[hg * 8 + i]);
#pragma unroll
            for (int i = 0; i < 8; ++i) p[hg * 8 + i] = dot2bf(pk[2 * jj + 1].y, w[i].w, p[hg * 8 + i]);
            __builtin_amdgcn_sched_barrier(0);
        }
    }
    float q8[8], q4[4], q2[2], q1;
    { const bool up = (lane & 32) != 0;
#pragma unroll
      for (int i = 0; i < 8; ++i) { const float send = up ? p[i] : p[i + 8], keep = up ? p[i + 8] : p[i]; q8[i] = keep + __shfl_xor(send, 32); } }
    { const bool up = (lane & 16) != 0;
#pragma unroll
      for (int i = 0; i < 4; ++i) { const float send = up ? q8[i] : q8[i + 4], keep = up ? q8[i + 4] : q8[i]; q4[i] = keep + __shfl_xor(send, 16); } }
    { const bool up = (lane & 8) != 0;
#pragma unroll
      for (int i = 0; i < 2; ++i) { const float send = up ? q4[i] : q4[i + 2], keep = up ? q4[i + 2] : q4[i]; q2[i] = keep + __shfl_xor(send, 8); } }
    { const bool up = (lane & 4) != 0; const float send = up ? q2[0] : q2[1], keep = up ? q2[1] : q2[0]; q1 = keep + __shfl_xor(send, 4); }
    q1 += __shfl_xor(q1, 2); q1 += __shfl_xor(q1, 1);
    if ((lane & 3) == 0) { const int h = ((lane >> 5) & 1) * 8 + ((lane >> 4) & 1) * 4 + ((lane >> 3) & 1) * 2 + ((lane >> 2) & 1);
        const float x = q1 + F.dt_bias[h]; F.DT[(size_t)r * 16 + h] = x > 20.f ? x : log1pf(expf(x)); }
}
template <bool LDSP>
__device__ __forceinline__ void ph1_proc(const Frame& F, int r, f32x4 (&v)[8], int mrow, const LAS u32x4* W2, const LAS f32x4* PT) {
    const int lane = F.lane; float ss = 0.f;
#pragma unroll
    for (int j = 0; j < 8; ++j) ss += (v[j][0] * v[j][0] + v[j][1] * v[j][1]) + (v[j][2] * v[j][2] + v[j][3] * v[j][3]);
    ss = wave_sum(ss);
    const float rs = 1.0f / sqrtf(ss * (1.0f / DM) + EPS);
    u32x2* orow = (u32x2*)(F.U + (size_t)r * DM); u32x2 pk[8];
#pragma unroll
    for (int j = 0; j < 8; ++j) {
        f32x4 pa, pb;
        if (LDSP) { pa = PT[lane + 64 * j]; pb = PT[512 + lane + 64 * j]; }
        else { pa = ((const f32x4*)F.g_pre_mix)[lane + 64 * j] * (mod4(F, mrow, 512 + lane + 64 * j) + 1.0f); pb = mod4(F, mrow, lane + 64 * j); }
        v[j] = (v[j] * rs) * pa + pb; pk[j] = (u32x2){cvtpk(v[j][0], v[j][1]), cvtpk(v[j][2], v[j][3])}; if (!LDSP) orow[lane + 64 * j] = pk[j];
        if (!LDSP && (j & 1)) asm volatile("" ::: "memory"); }
    if (LDSP) {
        float amax = 0.f;
#pragma unroll
        for (int j = 0; j < 8; ++j) amax = fmaxf(amax, fmaxf(fmaxf(fabsf(v[j][0]), fabsf(v[j][1])), fmaxf(fabsf(v[j][2]), fabsf(v[j][3]))));
        amax = fmaxf(wave_max(amax), 1e-20f);
        const float qs = 127.0f / amax;
        if (lane == 0) F.ASC1[r] = amax * (1.0f / 127.0f);
        unsigned* o8 = (unsigned*)(F.U18 + (size_t)r * DM);
#pragma unroll
        for (int j = 0; j < 8; ++j) o8[lane + 64 * j] = pack_i8(v[j][0] * qs, v[j][1] * qs, v[j][2] * qs, v[j][3] * qs);
    }
    dt_from_row(F, r, pk, W2);
}
__device__ __forceinline__ void ph1(Frame& F) {
    LAS u32x4* W2 = (LAS u32x4*)F.lds;
    LAS f32x4* PT = (LAS f32x4*)(F.lds + P1PRM_OFF);
    const int gw = F.bid * 8 + F.wave, NGW = F.G * 8, lane = F.lane;
    u32x4 wq[4]; const int wn0 = gw;
    if (gw < 4096) quant_load<4>(F.WinT + (size_t)wn0 * DM, lane, wq);
    u32x4 wq2[4]; const int gw2 = gw + NGW, wn1 = gw2;
    if (gw2 < 4096) quant_load<4>(F.WinT + (size_t)wn1 * DM, lane, wq2);
    for (int i = F.tid; i < 16 * 256; i += 512) { const int h = i >> 8, ln = i & 63, jj = (i >> 6) & 3;
        const f32x4 a = ((const f32x4*)F.WDT)[h * 512 + ln + 64 * (2 * jj)], b = ((const f32x4*)F.WDT)[h * 512 + ln + 64 * (2 * jj + 1)];
        W2[i] = (u32x4){cvtpk(a[0], a[1]), cvtpk(a[2], a[3]), cvtpk(b[0], b[1]), cvtpk(b[2], b[3])}; }
    { const int i = F.tid; PT[i] = ((const f32x4*)F.g_pre_mix)[i] * (mod4(F, 128, 512 + i) + 1.0f); PT[512 + i] = mod4(F, 128, i); }
    if (gw < 4096) quant_proc<4>(wq, F.Win8 + (size_t)wn0 * DM, F.WSC1 + wn0, lane);
    if (gw2 < 4096) quant_proc<4>(wq2, F.Win8 + (size_t)wn1 * DM, F.WSC1 + wn1, lane);
    for (int i = gw + 2 * NGW; i < 4096; i += NGW) { const int n = i;
        quant_row<4>(F.WinT + (size_t)n * DM, F.Win8 + (size_t)n * DM, F.WSC1 + n, lane); }
    __syncthreads();
    {
        const bool spread = F.G >= 2 * NB;
        const int rs0 = spread ? ((F.wave == 0 && !(F.bid & 1)) ? LP + (F.bid >> 1) : MT) : LP + gw, rstep = spread ? MT : NGW;
        for (int r = rs0; r < MT; r += rstep) {
            f32x4 v[8];
            row_load8(F.xs + (size_t)(r - LP) * DM, lane, v);
            ph1_proc<false>(F, r, v, r - LP, W2, PT);
        }
    }
    {
        f32x4 xa[8], xb[8];
        int r = gw;
        if (r < LP) row_load8(F.xp + (size_t)r * DM, lane, xa);
#pragma unroll 1
        for (; r < LP; r += 2 * NGW) {
            const int r1 = r + NGW, r2 = r1 + NGW;
            if (r1 < LP) row_load8(F.xp + (size_t)r1 * DM, lane, xb);
            ph1_proc<true>(F, r, xa, 128, W2, PT);
            if (r2 < LP) row_load8(F.xp + (size_t)r2 * DM, lane, xa);
            if (r1 < LP) ph1_proc<true>(F, r1, xb, 128, W2, PT);
        }
    }
}

template <int NCH>
__device__ __forceinline__ void conv_block(const bf16* base, int pitch, bool halo_valid, const float* cw, const float* cb, float (&out)[8][NCH]) {
    float w[4][NCH], b[NCH];
#pragma unroll
    for (int e = 0; e < NCH; e += 4) {
        const f32x4 bb = *(const f32x4*)(cb + e);
#pragma unroll
        for (int q = 0; q < 4; ++q) b[e + q] = bb[q];
#pragma unroll
        for (int i = 0; i < 4; ++i) { const f32x4 ww = *(const f32x4*)(cw + i * CONVD + e);
#pragma unroll
            for (int q = 0; q < 4; ++q) w[i][e + q] = ww[q]; }
    }
#pragma unroll
    for (int tt = 0; tt < 8; ++tt)
#pragma unroll
        for (int e = 0; e < NCH; ++e) out[tt][e] = b[e];
#pragma unroll
    for (int i = 0; i < 11; ++i) {
        float r[NCH];
        if (i < 3 && !halo_valid) {
#pragma unroll
            for (int e = 0; e < NCH; ++e) r[e] = 0.f;
        } else {
            if constexpr (NCH == 8) { const u32x4 q = *(const u32x4*)(base + (long)i * pitch);
                r[0] = bflo(q.x); r[1] = bfhi(q.x); r[2] = bflo(q.y); r[3] = bfhi(q.y); r[4] = bflo(q.z); r[5] = bfhi(q.z); r[6] = bflo(q.w); r[7] = bfhi(q.w); }
            else { const u32x2 q = *(const u32x2*)(base + (long)i * pitch); r[0] = bflo(q.x); r[1] = bfhi(q.x); r[2] = bflo(q.y); r[3] = bfhi(q.y); }
        }
#pragma unroll
        for (int tt = 0; tt < 8; ++tt) { const int j = i - tt; if (j >= 0 && j <= 3) {
#pragma unroll
            for (int e = 0; e < NCH; ++e) out[tt][e] += w[j][e] * r[e]; } }
    }
#pragma unroll
    for (int tt = 0; tt < 8; ++tt)
#pragma unroll
        for (int e = 0; e < NCH; ++e) out[tt][e] = silu_f(out[tt][e]);
}
__device__ __forceinline__ void conv8_load(const bf16* base, int pitch, bool halo_valid, u32x4 (&raw)[11]) {
#pragma unroll
    for (int i = 0; i < 11; ++i) { raw[i] = (u32x4){0u, 0u, 0u, 0u}; if (i >= 3 || halo_valid) raw[i] = *(const u32x4*)(base + (long)i * pitch); }
}
__device__ __forceinline__ void conv8_apply(const u32x4 (&raw)[11], const float* cw, const float* cb, float (&out)[8][8]) {
    float w[4][8], b[8];
#pragma unroll
    for (int e = 0; e < 8; e += 4) { const f32x4 bb = *(const f32x4*)(cb + e);
#pragma unroll
        for (int q = 0; q < 4; ++q) b[e + q] = bb[q];
#pragma unroll
        for (int i = 0; i < 4; ++i) { const f32x4 ww = *(const f32x4*)(cw + i * CONVD + e);
#pragma unroll
            for (int q = 0; q < 4; ++q) w[i][e + q] = ww[q]; } }
#pragma unroll
    for (int tt = 0; tt < 8; ++tt)
#pragma unroll
        for (int e = 0; e < 8; ++e) out[tt][e] = b[e];
#pragma unroll
    for (int i = 0; i < 11; ++i) {
        const float r[8] = {bflo(raw[i].x), bfhi(raw[i].x), bflo(raw[i].y), bfhi(raw[i].y), bflo(raw[i].z), bfhi(raw[i].z), bflo(raw[i].w), bfhi(raw[i].w)};
#pragma unroll
        for (int tt = 0; tt < 8; ++tt) { const int j = i - tt; if (j >= 0 && j <= 3) {
#pragma unroll
            for (int e = 0; e < 8; ++e) out[tt][e] += w[j][e] * r[e]; } }
    }
#pragma unroll
    for (int tt = 0; tt < 8; ++tt)
#pragma unroll
        for (int e = 0; e < 8; ++e) out[tt][e] = silu_f(out[tt][e]);
}
__device__ __forceinline__ void conv4_load(const bf16* base, int pitch, bool halo_valid, u32x2 (&raw)[11]) {
#pragma unroll
    for (int i = 0; i < 11; ++i) { raw[i] = (u32x2){0u, 0u}; if (i >= 3 || halo_valid) raw[i] = *(const u32x2*)(base + (long)i * pitch); }
}
__device__ __forceinline__ void conv4_apply(const u32x2 (&raw)[11], const float* cw, const float* cb, float (&out)[8][4]) {
    float w[4][4], b[4];
    { const f32x4 bb = *(const f32x4*)cb;
#pragma unroll
      for (int q = 0; q < 4; ++q) b[q] = bb[q];
#pragma unroll
      for (int i = 0; i < 4; ++i) { const f32x4 ww = *(const f32x4*)(cw + i * CONVD);
#pragma unroll
          for (int q = 0; q < 4; ++q) w[i][q] = ww[q]; } }
#pragma unroll
    for (int tt = 0; tt < 8; ++tt)
#pragma unroll
        for (int e = 0; e < 4; ++e) out[tt][e] = b[e];
#pragma unroll
    for (int i = 0; i < 11; ++i) {
        const float r[4] = {bflo(raw[i].x), bfhi(raw[i].x), bflo(raw[i].y), bfhi(raw[i].y)};
#pragma unroll
        for (int tt = 0; tt < 8; ++tt) { const int j = i - tt; if (j >= 0 && j <= 3) {
#pragma unroll
            for (int e = 0; e < 4; ++e) out[tt][e] += w[j][e] * r[e]; } }
    }
#pragma unroll
    for (int tt = 0; tt < 8; ++tt)
#pragma unroll
        for (int e = 0; e < 4; ++e) out[tt][e] = silu_f(out[tt][e]);
}
__device__ __forceinline__ float chunk_acum(const Frame& F, int c, int h, float& d0, float& d1, float& ac0, float& ac1) {
    const float a = -expf(F.a_log[h]);
    const int t = c * 128 + 2 * F.lane;
    d0 = F.DT[(size_t)t * 16 + h]; d1 = F.DT[(size_t)(t + 1) * 16 + h];
    float v = (d0 + d1) * a;
#pragma unroll
    for (int o = 1; o < 64; o <<= 1) { const float n = __shfl_up(v, o); if (F.lane >= o) v += n; }
    ac1 = v; ac0 = v - d1 * a;
    return __shfl(v, 63);
}

__device__ __forceinline__ void ssd_a_item(Frame& F, int c, int g) {
    LAS unsigned char* lds = F.lds;
    const int lane = F.lane, hh = F.wave, h = g * 8 + hh, t0 = c * 128;
    LAS float* coef = (LAS float*)(lds + 98304) + hh * 128;
    u32x4 rawB[11], rawX[11];
    const int bco = F.tid & 15, bto = (F.tid >> 4) & 15, xco = lane & 3, xto = lane >> 2;
    if (F.tid < 256) conv8_load(F.PROJ + proj_b(g) + (long)(t0 + 8 * bto - 3) * 128 + 8 * bco, 128, (c > 0) || (bto > 0), rawB);
    conv8_load(F.PROJ + proj_x(h) + (long)(t0 + 8 * xto - 3) * 64 + 8 * xco, 64, (c > 0) || (xto > 0), rawX);
    {
        float d0, d1, ac0, ac1; const float tot = chunk_acum(F, c, h, d0, d1, ac0, ac1);
        coef[2 * lane] = d0 * __expf(tot - ac0); coef[2 * lane + 1] = d1 * __expf(tot - ac1);
        if (lane == 0) F.DECAY[c * 16 + h] = __expf(tot);
    }
    if (F.tid < 256) {
        const int co = bco, to = bto; float o[8][8];
        const int ch = 1024 + g * 128 + 8 * co;
        conv8_apply(rawB, F.conv_w + ch, F.conv_b + ch, o);
#pragma unroll
        for (int e = 0; e < 8; ++e) { const int n = 8 * co + e;
            u32x4 w; w.x = cvtpk(o[0][e], o[1][e]); w.y = cvtpk(o[2][e], o[3][e]); w.z = cvtpk(o[4][e], o[5][e]); w.w = cvtpk(o[6][e], o[7][e]);
            *(LAS u32x4*)(lds + n * 256 + ((to ^ (n & 15)) * 16)) = w; }
    }
    __syncthreads();
    LAS unsigned char* xt = lds + 32768 + hh * 8192;
    const int fr = lane & 15, fq = lane >> 4;
#pragma unroll 1
    for (int ph = 0; ph < 2; ++ph) {
        {
            const int co = xco, to = xto; float o[8][8];
            const int ch = h * 64 + 32 * ph + 8 * co;
            conv8_apply(rawX, F.conv_w + ch, F.conv_b + ch, o);
            if (ph == 0) conv8_load(F.PROJ + proj_x(h) + (long)(t0 + 8 * xto - 3) * 64 + 32 + 8 * xco, 64, (c > 0) || (xto > 0), rawX);
            float cf[8];
#pragma unroll
            for (int tt = 0; tt < 8; ++tt) cf[tt] = coef[8 * to + tt];
#pragma unroll
            for (int e = 0; e < 8; ++e) { const int pl = 8 * co + e;
                u32x4 w; w.x = cvtpk(o[0][e] * cf[0], o[1][e] * cf[1]); w.y = cvtpk(o[2][e] * cf[2], o[3][e] * cf[3]); w.z = cvtpk(o[4][e] * cf[4], o[5][e] * cf[5]); w.w = cvtpk(o[6][e] * cf[6], o[7][e] * cf[7]);
                *(LAS u32x4*)(xt + pl * 256 + ((to ^ (pl & 15)) * 16)) = w; }
        }
        LDS_WAIT();
        f32x4 acc[8][2];
#pragma unroll
        for (int nf = 0; nf < 8; ++nf) { acc[nf][0] = (f32x4){0.f, 0.f, 0.f, 0.f}; acc[nf][1] = (f32x4){0.f, 0.f, 0.f, 0.f}; }
#pragma unroll
        for (int ks = 0; ks < 4; ++ks) {
            bf16x8 xb[2];
#pragma unroll
            for (int pf = 0; pf < 2; ++pf) { const int p = 16 * pf + fr; xb[pf] = *(const LAS bf16x8*)(xt + p * 256 + (((4 * ks + fq) ^ (p & 15)) * 16)); }
#pragma unroll
            for (int nf = 0; nf < 8; ++nf) { const int n = 16 * nf + fr; const bf16x8 ba = *(const LAS bf16x8*)(lds + n * 256 + (((4 * ks + fq) ^ (n & 15)) * 16));
                acc[nf][0] = __builtin_amdgcn_mfma_f32_16x16x32_bf16(ba, xb[0], acc[nf][0], 0, 0, 0);
                acc[nf][1] = __builtin_amdgcn_mfma_f32_16x16x32_bf16(ba, xb[1], acc[nf][1], 0, 0, 0); }
        }
        bf16* sb = F.STATES + ((size_t)(c * 16 + h) * 64 + 32 * ph) * 128;
#pragma unroll
        for (int nf = 0; nf < 8; ++nf)
#pragma unroll
            for (int pf = 0; pf < 2; ++pf) *(u32x2*)(sb + (size_t)(16 * pf + fr) * 128 + 16 * nf + 4 * fq) = (u32x2){cvtpk(acc[nf][pf][0], acc[nf][pf][1]), cvtpk(acc[nf][pf][2], acc[nf][pf][3])};
        LDS_WAIT();
    }
    __syncthreads();
}

__device__ __forceinline__ void attn_stage(Frame& F, int qb, int kvh, LAS unsigned char* lds) {
    const int tid = F.tid;
    if (tid >= 256) {
        const int t2 = tid - 256;
#pragma unroll
        for (int i = 0; i < 8; ++i) { const int idx = t2 + 256 * i, key = idx >> 3, ch = idx & 7; const int row = qb * 128 - 128 + key;
            u32x4 v = (u32x4){0u, 0u, 0u, 0u};
            if (row >= 0) v = *(const u32x4*)(F.PROJ + proj_k(kvh) + (size_t)row * 64 + ch * 8);
            *(LAS u32x4*)(lds + key * 128 + ((ch ^ ((key >> 1) & 7)) * 16)) = v; }
    } else {
        const int ko = tid >> 3, dq = tid & 7; u32x4 v[8];
#pragma unroll
        for (int i = 0; i < 8; ++i) { const int row = qb * 128 - 128 + 8 * ko + i; v[i] = (u32x4){0u, 0u, 0u, 0u};
            if (row >= 0) v[i] = *(const u32x4*)(F.PROJ + proj_v(kvh) + (size_t)row * 64 + dq * 8); }
#pragma unroll
        for (int e = 0; e < 8; ++e) { const int d = 8 * dq + e; u32x4 w;
            const int sh = (e & 1) * 16;
#define VSEL(i) ((e < 2 ? v[i].x : e < 4 ? v[i].y : e < 6 ? v[i].z : v[i].w) >> sh & 0xffffu)
            w.x = VSEL(0) | (VSEL(1) << 16); w.y = VSEL(2) | (VSEL(3) << 16); w.z = VSEL(4) | (VSEL(5) << 16); w.w = VSEL(6) | (VSEL(7) << 16);
#undef VSEL
            *(LAS u32x4*)(lds + 32768 + d * 512 + ((ko ^ (d & 31)) * 16)) = w; }
    }
}
template <bool FIRST>
__device__ __forceinline__ void attn_compute_t(Frame& F, int qb, int kvh, LAS unsigned char* lds) {
    const int lane = F.lane;
    const int g = F.wave >> 1, head = kvh * 4 + g, qhalf = F.wave & 1, ql = lane & 31, hi = lane >> 5;
    const float slope2 = LOG2E * exp2f(-0.5f * (float)(head + 1)), sink2 = F.sinks[head] * LOG2E;
#pragma unroll 1
    for (int pass = 0; pass < 2; ++pass) {
        const int a0 = qhalf * 64 + pass * 32, a = a0 + ql; const size_t qrow = (size_t)qb * 128 + a;
        bf16x8 qf[4];
#pragma unroll
        for (int ks = 0; ks < 4; ++ks) qf[ks] = *(const bf16x8*)(F.PROJ + proj_q(head) + qrow * 64 + 16 * ks + 8 * hi);
        const int lq = ql - 4 * hi; const float nb = -slope2 * ((float)lq + 128.0f);
        const int t0 = 128 - a0 - 4 * hi;
        float m = sink2, l = 0.f;
        f32x16 o0 = {}, o1 = {};
#pragma unroll
        for (int kk = 0; kk < 5; ++kk) {
            const int kt = 4 - kk;
            f32x16 st = {};
            const int key = a0 + 32 * kt + ql;
#pragma unroll
            for (int ks = 0; ks < 4; ++ks) { const bf16x8 kf = *(const LAS bf16x8*)(lds + key * 128 + (((2 * ks + hi) ^ ((key >> 1) & 7)) * 16));
                st = __builtin_amdgcn_mfma_f32_32x32x16_bf16(kf, qf[ks], st, 0, 0, 0); }
            float tm = -INFINITY;
#pragma unroll
            for (int r = 0; r < 16; ++r) { const int cr = (r & 3) + 8 * (r >> 2);
                float s2 = st[r] * (0.125f * LOG2E) + (nb + slope2 * (float)(32 * kt + cr));
                if (FIRST || kt == 0 || kt == 4) {
                    bool ok = true;
                    if (FIRST) ok = (32 * kt + cr) >= t0;
                    if (kt == 0) ok = ok && (cr > lq);
                    if (kt == 4) ok = ok && (cr <= lq);
                    s2 = ok ? s2 : -INFINITY;
                }
                st[r] = s2; tm = fmaxf(tm, s2); }
            tm = fmaxf(tm, __shfl_xor(tm, 32));
            if (__any(tm > m)) {
                const float mn = fmaxf(m, tm), f = __builtin_amdgcn_exp2f(m - mn);
#pragma unroll
                for (int r = 0; r < 16; ++r) { o0[r] *= f; o1[r] *= f; }
                l *= f; m = mn;
            }
#pragma unroll
            for (int r = 0; r < 16; ++r) { const float p = __builtin_amdgcn_exp2f(st[r] - m); st[r] = p; l += p; }
#pragma unroll
            for (int s = 0; s < 2; ++s) {
                u32x4 pw; pw.x = cvtpk(st[8 * s + 0], st[8 * s + 1]); pw.y = cvtpk(st[8 * s + 2], st[8 * s + 3]); pw.z = cvtpk(st[8 * s + 4], st[8 * s + 5]); pw.w = cvtpk(st[8 * s + 6], st[8 * s + 7]);
                const bf16x8 pf = __builtin_bit_cast(bf16x8, pw);
                const int kc = ((a0 + 32 * kt) >> 3) + 2 * s;
#pragma unroll
                for (int db = 0; db < 2; ++db) { const int d = 32 * db + ql;
                    const u32x2 lo = *(const LAS u32x2*)(lds + 32768 + d * 512 + ((kc ^ (d & 31)) * 16) + 8 * hi);
                    const u32x2 hi2 = *(const LAS u32x2*)(lds + 32768 + d * 512 + (((kc + 1) ^ (d & 31)) * 16) + 8 * hi);
                    const u32x4 vw = (u32x4){lo.x, lo.y, hi2.x, hi2.y};
                    const bf16x8 vf = __builtin_bit_cast(bf16x8, vw);
                    if (db == 0) o0 = __builtin_amdgcn_mfma_f32_32x32x16_bf16(vf, pf, o0, 0, 0, 0); else o1 = __builtin_amdgcn_mfma_f32_32x32x16_bf16(vf, pf, o1, 0, 0, 0); }
            }
        }
        l += __shfl_xor(l, 32);
        l += __builtin_amdgcn_exp2f(sink2 - m);
        const float inv = 1.0f / l; float ssq = 0.f;
#pragma unroll
        for (int r = 0; r < 16; ++r) { o0[r] *= inv; o1[r] *= inv; ssq += o0[r] * o0[r] + o1[r] * o1[r]; }
        ssq += __shfl_xor(ssq, 32);
        if (hi == 0) F.SSQA[qrow * 16 + head] = ssq;
        bf16* orow = F.MIX + qrow * DM + head * 64;
#pragma unroll
        for (int rq = 0; rq < 4; ++rq) {
            const int d0 = 8 * rq + 4 * hi;
            *(u32x2*)(orow + d0) = (u32x2){cvtpk(o0[4 * rq], o0[4 * rq + 1]), cvtpk(o0[4 * rq + 2], o0[4 * rq + 3])};
            *(u32x2*)(orow + 32 + d0) = (u32x2){cvtpk(o1[4 * rq], o1[4 * rq + 1]), cvtpk(o1[4 * rq + 2], o1[4 * rq + 3])};
        }
    }
}

__device__ __forceinline__ void attn_compute(Frame& F, int qb, int kvh, LAS unsigned char* lds) {
    if (qb == 0) attn_compute_t<true>(F, qb, kvh, lds); else attn_compute_t<false>(F, qb, kvh, lds);
}

__device__ __forceinline__ void sample_attn_pair(Frame& F, int item0) {
    const int lane = F.lane, w = F.wave, it = item0 + (w >> 2), kq = w & 3, b = it >> 2, kvh = it & 3;
    LAS float* pl = (LAS float*)(F.lds + w * 512);
    LAS float* part = (LAS float*)(F.lds + 4096 + w * 1088);
    const float* trow = F.TAIL + (size_t)(128 + b) * NPROJ;
    const float* q = trow + C_Q + kvh * 256;
    const float* Kc = F.cache_k + ((size_t)b * 128 * 4 + kvh) * 64; const float* Vc = F.cache_v + ((size_t)b * 128 * 4 + kvh) * 64;
    float* Ko = F.out + O_KS + ((size_t)b * 128 * 4 + kvh) * 64; float* Vo = F.out + O_VS + ((size_t)b * 128 * 4 + kvh) * 64;
    const int ks = lane >> 4, d4 = lane & 15;
    f32x4 kv[8];
#pragma unroll
    for (int i = 0; i < 8; ++i) kv[i] = __builtin_nontemporal_load((const f32x4*)(Kc + (size_t)(32 * kq + 4 * i + ks) * 256 + 4 * d4));
    float vv[32];
#pragma unroll
    for (int j = 0; j < 32; ++j) vv[j] = __builtin_nontemporal_load(Vc + (size_t)(32 * kq + j) * 256 + lane);
    f32x4 qv[4];
#pragma unroll
    for (int g = 0; g < 4; ++g) qv[g] = *(const f32x4*)(q + g * 64 + 4 * d4);
    float sc[8][4];
#pragma unroll
    for (int i = 0; i < 8; ++i) {
        const int key = 32 * kq + 4 * i + ks;
        if (key >= 1) *(f32x4*)(Ko + (size_t)(key - 1) * 256 + 4 * d4) = kv[i];
#pragma unroll
        for (int g = 0; g < 4; ++g) { float t = (kv[i][0] * qv[g][0] + kv[i][1] * qv[g][1]) + (kv[i][2] * qv[g][2] + kv[i][3] * qv[g][3]);
            t += __shfl_xor(t, 1); t += __shfl_xor(t, 2); t += __shfl_xor(t, 4); t += __shfl_xor(t, 8); sc[i][g] = t; }
    }
    float mloc[4], lloc[4];
#pragma unroll
    for (int g = 0; g < 4; ++g) {
        const int head = kvh * 4 + g; const float slope2 = LOG2E * exp2f(-0.5f * (float)(head + 1));
        float m = -1e30f;
#pragma unroll
        for (int i = 0; i < 8; ++i) { const int key = 32 * kq + 4 * i + ks;
            sc[i][g] = (key >= 1) ? sc[i][g] * (0.125f * LOG2E) - slope2 * (float)(128 - key) : -INFINITY; m = fmaxf(m, sc[i][g]); }
        m = fmaxf(m, __shfl_xor(m, 16)); m = fmaxf(m, __shfl_xor(m, 32));
        float l = 0.f;
#pragma unroll
        for (int i = 0; i < 8; ++i) { const float p = __builtin_amdgcn_exp2f(sc[i][g] - m); l += p; if (d4 == 0) pl[(4 * i + ks) * 4 + g] = p; }
        l += __shfl_xor(l, 16); l += __shfl_xor(l, 32);
        mloc[g] = m; lloc[g] = l;
    }
    LDS_WAIT();
    float o[4] = {0.f, 0.f, 0.f, 0.f};
#pragma unroll
    for (int j = 0; j < 32; ++j) {
        const int kj = 32 * kq + j;
        if (kj >= 1) Vo[(size_t)(kj - 1) * 256 + lane] = vv[j];
        const f32x4 pj = *(const LAS f32x4*)(pl + j * 4);
        o[0] += pj[0] * vv[j]; o[1] += pj[1] * vv[j]; o[2] += pj[2] * vv[j]; o[3] += pj[3] * vv[j];
    }
    if (lane < 4) { part[lane] = (lane == 0) ? mloc[0] : (lane == 1) ? mloc[1] : (lane == 2) ? mloc[2] : mloc[3];
                    part[4 + lane] = (lane == 0) ? lloc[0] : (lane == 1) ? lloc[1] : (lane == 2) ? lloc[2] : lloc[3]; }
#pragma unroll
    for (int g = 0; g < 4; ++g) part[16 + g * 64 + lane] = o[g];
    __syncthreads();
    if (kq == 0) {
        const float kn = trow[C_K + kvh * 64 + lane], vn = trow[C_V + kvh * 64 + lane];
        Ko[127 * 256 + lane] = kn; Vo[127 * 256 + lane] = vn;
        const size_t row = (size_t)LP + b;
#pragma unroll
        for (int g = 0; g < 4; ++g) {
            const int head = kvh * 4 + g; const float sink2 = F.sinks[head] * LOG2E;
            const float sn = wave_sum(kn * q[g * 64 + lane]) * (0.125f * LOG2E);
            float m = fmaxf(sn, sink2);
#pragma unroll
            for (int qq = 0; qq < 4; ++qq) m = fmaxf(m, part[qq * 272 + g]);
            float l = __builtin_amdgcn_exp2f(sn - m) + __builtin_amdgcn_exp2f(sink2 - m), ov = __builtin_amdgcn_exp2f(sn - m) * vn;
#pragma unroll
            for (int qq = 0; qq < 4; ++qq) { const float f = __builtin_amdgcn_exp2f(part[qq * 272 + g] - m); l += f * part[qq * 272 + 4 + g]; ov += f * part[qq * 272 + 16 + g * 64 + lane]; }
            ov = ov / l;
            const float ssq = wave_sum(ov * ov);
            if (lane == 0) F.SSQA[row * 16 + head] = ssq;
            F.MIX[row * DM + head * 64 + lane] = (bf16)(cvtpk(ov, 0.f) & 0xffffu);
        }
    }
    __syncthreads();
}
__device__ __forceinline__ void sample_ssd_item(Frame& F, int b, int h) {
    const int lane = F.lane, g = h >> 3, nq = lane & 15, prow = lane >> 4;
    const float* trow = F.TAIL + (size_t)(128 + b) * NPROJ;
    const float* sc = F.state_conv + (size_t)b * 3 * CONVD;
    float xs_l;
    { const int ch = h * 64 + lane;
      float y = F.conv_b[ch] + sc[ch] * F.conv_w[ch] + sc[CONVD + ch] * F.conv_w[CONVD + ch] + sc[2 * CONVD + ch] * F.conv_w[2 * CONVD + ch] + trow[C_X + ch] * F.conv_w[3 * CONVD + ch];
      xs_l = silu_f(y); }
    float Bv[8], Cv[8];
#pragma unroll
    for (int e = 0; e < 8; ++e) {
        { const int ch = 1024 + g * 128 + 8 * nq + e;
          float y = F.conv_b[ch] + sc[ch] * F.conv_w[ch] + sc[CONVD + ch] * F.conv_w[CONVD + ch] + sc[2 * CONVD + ch] * F.conv_w[2 * CONVD + ch] + trow[C_X + ch] * F.conv_w[3 * CONVD + ch];
          Bv[e] = silu_f(y); }
        { const int ch = 1280 + g * 128 + 8 * nq + e;
          float y = F.conv_b[ch] + sc[ch] * F.conv_w[ch] + sc[CONVD + ch] * F.conv_w[CONVD + ch] + sc[2 * CONVD + ch] * F.conv_w[2 * CONVD + ch] + trow[C_X + ch] * F.conv_w[3 * CONVD + ch];
          Cv[e] = silu_f(y); }
    }
    const size_t row = (size_t)LP + b;
    const float dt = F.DT[row * 16 + h], a = -expf(F.a_log[h]), dec = expf(dt * a), dsk = F.d_skip[h];
    const float* h0 = F.state_ssm + ((size_t)(b * 16 + h) * 64) * 128; float* ho = F.out + O_HS + ((size_t)(b * 16 + h) * 64) * 128;
    float ykeep = 0.f;
#pragma unroll 4
    for (int st = 0; st < 16; ++st) {
        const int p = 4 * st + prow; const float xp = __shfl(xs_l, p) * dt;
        const f32x4 a0 = __builtin_nontemporal_load((const f32x4*)(h0 + (size_t)p * 128 + 8 * nq)), a1 = __builtin_nontemporal_load((const f32x4*)(h0 + (size_t)p * 128 + 8 * nq + 4));
        f32x4 n0, n1; float part = 0.f;
#pragma unroll
        for (int e = 0; e < 4; ++e) { n0[e] = a0[e] * dec + xp * Bv[e]; n1[e] = a1[e] * dec + xp * Bv[4 + e]; part += n0[e] * Cv[e] + n1[e] * Cv[4 + e]; }
        *(f32x4*)(ho + (size_t)p * 128 + 8 * nq) = n0; *(f32x4*)(ho + (size_t)p * 128 + 8 * nq + 4) = n1;
        part += __shfl_xor(part, 1); part += __shfl_xor(part, 2); part += __shfl_xor(part, 4); part += __shfl_xor(part, 8);
        if (nq == st) ykeep = part;
    }
    const int pm = 4 * nq + prow;
    const float xm = __shfl(xs_l, pm), z = trow[C_Z + h * 64 + pm];
    const float y = (ykeep + dsk * xm) * silu_f(z);
    const float ssq = wave_sum(y * y);
    if (lane == 0) F.SSQS[row * 16 + h] = ssq;
    F.MIX[row * DM + 1024 + h * 64 + pm] = (bf16)(cvtpk(y, 0.f) & 0xffffu);
}

__device__ __forceinline__ void ph3(Frame& F) {
    for (int rep = 0; rep < 1 + ((PROBE_SUB >> 0) & 1); ++rep)
    for (int it = F.bid; it < 256; it += F.G) ssd_a_item(F, it >> 1, it & 1);
    for (int rep = 0; rep < 1 + ((PROBE_SUB >> 1) & 1); ++rep)
    for (int it = F.bid; it < 512; it += 2 * F.G) {
        const int it2 = it + F.G;
        attn_stage(F, it >> 2, it & 3, F.lds);
        if (it2 < 512) attn_stage(F, it2 >> 2, it2 & 3, F.lds + 65536);
        __syncthreads();
        attn_compute(F, it >> 2, it & 3, F.lds);
        if (it2 < 512) attn_compute(F, it2 >> 2, it2 & 3, F.lds + 65536);
        __syncthreads();
    }
    for (int rep = 0; rep < 1 + ((PROBE_SUB >> 2) & 1); ++rep)
    for (int wi = F.bid * 8 + F.wave; wi < NB * 16; wi += F.G * 8) sample_ssd_item(F, wi >> 4, wi & 15);
    for (int rep = 0; rep < 1 + ((PROBE_SUB >> 3) & 1); ++rep)
    for (int it = F.bid; it < NB * 2; it += F.G) sample_attn_pair(F, 2 * it);
    for (int i = F.bid * 512 + F.tid; i < 129 * 2048; i += 2 * F.G * 512) {
        const int i1 = i + F.G * 512; const bool h1 = i1 < 129 * 2048;
        const f32x4 r0 = mod4(F, i >> 11, 1024 + (i & 2047));
        f32x4 r1 = r0; if (h1) r1 = mod4(F, i1 >> 11, 1024 + (i1 & 2047));
        ((f32x4*)F.MODF)[i] = r0; if (h1) ((f32x4*)F.MODF)[i1] = r1;
    }
    const int gt = F.bid * 512 + F.tid, NT = F.G * 512;
    for (int i = gt; i < 8192; i += NT) { const int j = i >> 6, cc = (i & 63) * 4;
        const f32x4 kk = *(const f32x4*)(F.TAIL + (size_t)j * NPROJ + C_K + cc), vv = *(const f32x4*)(F.TAIL + (size_t)j * NPROJ + C_V + cc);
        *(f32x4*)(F.out + O_KP + 4 * i) = kk; *(f32x4*)(F.out + O_VP + 4 * i) = vv; }
    for (int i = gt; i < 3 * CONVD / 4; i += NT) { const int r = i / (CONVD / 4), ch = (i % (CONVD / 4)) * 4; *(f32x4*)(F.out + O_CP + 4 * i) = *(const f32x4*)(F.TAIL + (size_t)(125 + r) * NPROJ + C_X + ch); }
    for (int i = gt; i < NB * 3 * CONVD / 4; i += NT) { const int b = i / (3 * CONVD / 4), r = (i / (CONVD / 4)) % 3, ch = (i % (CONVD / 4)) * 4;
        const float* src = (r < 2) ? F.state_conv + (size_t)(b * 3 + r + 1) * CONVD + ch : F.TAIL + (size_t)(128 + b) * NPROJ + C_X + ch;
        *(f32x4*)(F.out + O_CS + 4 * i) = *(const f32x4*)src; }
}

__device__ __forceinline__ void ph4(Frame& F) {
    for (int e = F.bid * 512 + F.tid; e < 131072; e += F.G * 512) {
        const int h = e >> 13; float hv = 0.f;
#pragma unroll 1
        for (int c0 = 0; c0 < 128; c0 += 32) {
            float s[32], d[32];
#pragma unroll
            for (int i = 0; i < 32; ++i) { s[i] = __uint_as_float((unsigned)__builtin_nontemporal_load(F.STATES + (size_t)(c0 + i) * 131072 + e) << 16); d[i] = F.DECAY[(c0 + i) * 16 + h]; }
#pragma unroll
            for (int i = 0; i < 32; ++i) { F.HPREV[(size_t)(c0 + i) * 131072 + e] = (bf16)(cvtpk(hv, 0.f) & 0xffffu); hv = hv * d[i] + s[i]; }
        }
        F.out[O_HP + e] = hv;
    }
}

__device__ __forceinline__ void ssd_c_item(Frame& F, int c, int g) {
    LAS unsigned char* lds = F.lds;
    const int lane = F.lane, w = F.wave, tid = F.tid, t0 = c * 128, fr = lane & 15, fq = lane >> 4;
    LAS float* acl = (LAS float*)(lds + 98304); LAS float* dtl = (LAS float*)(lds + 102400);
    {
        float d0, d1, ac0, ac1; (void)chunk_acum(F, c, g * 8 + w, d0, d1, ac0, ac1);
        acl[w * 128 + 2 * lane] = ac0; acl[w * 128 + 2 * lane + 1] = ac1; dtl[w * 128 + 2 * lane] = d0; dtl[w * 128 + 2 * lane + 1] = d1;
    }
    {
        const int isC = tid >> 8, t2 = tid & 255, co = t2 & 15, to = t2 >> 4; float o[8][8];
        const int ch = (isC ? 1280 : 1024) + g * 128 + 8 * co;
        conv_block<8>(F.PROJ + (isC ? proj_c(g) : proj_b(g)) + (long)(t0 + 8 * to - 3) * 128 + 8 * co, 128, (c > 0) || (to > 0), F.conv_w + ch, F.conv_b + ch, o);
        LAS unsigned char* img = lds + (isC ? 0 : 32768);
#pragma unroll
        for (int tt = 0; tt < 8; ++tt) { const int t = 8 * to + tt;
            u32x4 wv; wv.x = cvtpk(o[tt][0], o[tt][1]); wv.y = cvtpk(o[tt][2], o[tt][3]); wv.z = cvtpk(o[tt][4], o[tt][5]); wv.w = cvtpk(o[tt][6], o[tt][7]);
            *(LAS u32x4*)(img + t * 256 + ((co ^ (t & 15)) * 16)) = wv; }
    }
    __syncthreads();
    f32x4 cb[8];
#pragma unroll
    for (int sf = 0; sf < 8; ++sf) cb[sf] = (f32x4){0.f, 0.f, 0.f, 0.f};
    {
        const int l = 16 * w + fr;
#pragma unroll
        for (int ks = 0; ks < 4; ++ks) {
            const bf16x8 cf = *(const LAS bf16x8*)(lds + l * 256 + (((4 * ks + fq) ^ (l & 15)) * 16));
            bf16x8 bfr[8];
#pragma unroll
            for (int sf = 0; sf < 8; ++sf) if (sf <= w) { const int s = 16 * sf + fr;
                bfr[sf] = *(const LAS bf16x8*)(lds + 32768 + s * 256 + (((4 * ks + fq) ^ (s & 15)) * 16)); }
            __builtin_amdgcn_sched_barrier(0);
#pragma unroll
            for (int sf = 0; sf < 8; ++sf) if (sf <= w) cb[sf] = __builtin_amdgcn_mfma_f32_16x16x32_bf16(bfr[sf], cf, cb[sf], 0, 0, 0);
            __builtin_amdgcn_sched_barrier(0);
        }
    }
    __syncthreads();
    const int l = 16 * w + fr; const size_t trow = (size_t)t0 + l;
    const int co4 = tid & 15, cto = (tid >> 4) & 15;
    u32x2 rawc[11], rawn[11];
    if (tid < 256) conv4_load(F.PROJ + proj_x(g * 8) + (long)(t0 + 8 * cto - 3) * 64 + 4 * co4, 64, (c > 0) || (cto > 0), rawc);
    const int hp_p = tid >> 3, hp_c = (tid & 7) * 2;
    u32x4 hq0, hq1; u32x2 zw[4], zn[4];
    { const bf16* hp = F.HPREV + ((size_t)(c * 16 + g * 8) * 64) * 128 + (size_t)hp_p * 128 + hp_c * 8;
      hq0 = *(const u32x4*)hp; hq1 = *(const u32x4*)(hp + 8);
      const bf16* zp = F.PROJ + proj_z(g * 8) + trow * 64;
#pragma unroll
      for (int pf = 0; pf < 4; ++pf) zn[pf] = *(const u32x2*)(zp + 16 * pf + 4 * fq);
      *(LAS u32x4*)(lds + 106496 + hp_p * 256 + ((hp_c ^ (hp_p & 15)) * 16)) = hq0; *(LAS u32x4*)(lds + 106496 + hp_p * 256 + (((hp_c + 1) ^ (hp_p & 15)) * 16)) = hq1; }
    __syncthreads();
#pragma unroll 1
    for (int hh = 0; hh < 8; ++hh) {
        const int h = g * 8 + hh;
        if (tid < 256 && hh < 7) conv4_load(F.PROJ + proj_x(h + 1) + (long)(t0 + 8 * cto - 3) * 64 + 4 * co4, 64, (c > 0) || (cto > 0), rawn);
        if (hh < 7) {
            const bf16* hp = F.HPREV + ((size_t)(c * 16 + h + 1) * 64) * 128 + (size_t)hp_p * 128 + hp_c * 8;
            hq0 = *(const u32x4*)hp; hq1 = *(const u32x4*)(hp + 8);
        }
#pragma unroll
        for (int pf = 0; pf < 4; ++pf) zw[pf] = zn[pf];
        if (hh < 7) { const bf16* zp = F.PROJ + proj_z(h + 1) + trow * 64;
#pragma unroll
            for (int pf = 0; pf < 4; ++pf) zn[pf] = *(const u32x2*)(zp + 16 * pf + 4 * fq); }
        {
            const float al = acl[hh * 128 + l];
            f32x4 avn = *(const LAS f32x4*)(acl + hh * 128 + 4 * fq);
#pragma unroll
            for (int sf = 0; sf < 8; ++sf) if (sf <= (w | 1)) {
                const f32x4 av = avn;
                if (sf + 1 < 8 && sf + 1 <= (w | 1)) avn = *(const LAS f32x4*)(acl + hh * 128 + 16 * (sf + 1) + 4 * fq);
                const int s0 = 16 * sf + 4 * fq; float mv[4];
#pragma unroll
                for (int r = 0; r < 4; ++r) { const int sx = s0 + r; const float ev = cb[sf][r] * __expf(fminf(al - av[r], 0.f)); mv[r] = (sf <= w && sx <= l) ? ev : 0.f; }
                *(LAS u32x2*)(lds + 32768 + l * 256 + (((s0 >> 3) ^ (l & 15)) * 16) + (s0 & 7) * 2) = (u32x2){cvtpk(mv[0], mv[1]), cvtpk(mv[2], mv[3])};
            }
        }
        f32x4 y1[4], y2[4];
#pragma unroll
        for (int pf = 0; pf < 4; ++pf) { y1[pf] = (f32x4){0.f, 0.f, 0.f, 0.f}; y2[pf] = (f32x4){0.f, 0.f, 0.f, 0.f}; }
#pragma unroll
        for (int kp = 0; kp < 2; ++kp) {
            bf16x8 cf[2], hfr[2][4];
#pragma unroll
            for (int k2 = 0; k2 < 2; ++k2) { const int ks = 2 * kp + k2;
                cf[k2] = *(const LAS bf16x8*)(lds + l * 256 + (((4 * ks + fq) ^ (l & 15)) * 16));
#pragma unroll
                for (int pf = 0; pf < 4; ++pf) { const int p = 16 * pf + fr; hfr[k2][pf] = *(const LAS bf16x8*)(lds + 106496 + p * 256 + (((4 * ks + fq) ^ (p & 15)) * 16)); } }
            __builtin_amdgcn_sched_barrier(0);
#pragma unroll
            for (int k2 = 0; k2 < 2; ++k2)
#pragma unroll
                for (int pf = 0; pf < 4; ++pf) y2[pf] = __builtin_amdgcn_mfma_f32_16x16x32_bf16(hfr[k2][pf], cf[k2], y2[pf], 0, 0, 0);
            __builtin_amdgcn_sched_barrier(0);
        }
        if (tid < 256) {
            float o[8][4];
            const int ch = h * 64 + 4 * co4;
            conv4_apply(rawc, F.conv_w + ch, F.conv_b + ch, o);
#pragma unroll
            for (int tt = 0; tt < 8; ++tt) { const int t = 8 * cto + tt;
                *(LAS u32x2*)(lds + 81920 + t * 128 + co4 * 8) = (u32x2){cvtpk(o[tt][0], o[tt][1]), cvtpk(o[tt][2], o[tt][3])}; }
            float dv[8];
#pragma unroll
            for (int tt = 0; tt < 8; ++tt) dv[tt] = dtl[hh * 128 + 8 * cto + tt];
#pragma unroll
            for (int e = 0; e < 4; ++e) { const int p = 4 * co4 + e;
                u32x4 wv; wv.x = cvtpk(o[0][e] * dv[0], o[1][e] * dv[1]); wv.y = cvtpk(o[2][e] * dv[2], o[3][e] * dv[3]); wv.z = cvtpk(o[4][e] * dv[4], o[5][e] * dv[5]); wv.w = cvtpk(o[6][e] * dv[6], o[7][e] * dv[7]);
                *(LAS u32x4*)(lds + 65536 + p * 256 + ((cto ^ (p & 15)) * 16)) = wv; }
#pragma unroll
            for (int i = 0; i < 11; ++i) rawc[i] = rawn[i];
        }
        __syncthreads();
#pragma unroll
        for (int ks = 0; ks < 4; ++ks) {
            if (32 * ks <= 16 * w + 15) {
                const bf16x8 mf = *(const LAS bf16x8*)(lds + 32768 + l * 256 + (((4 * ks + fq) ^ (l & 15)) * 16));
                bf16x8 xf[4];
#pragma unroll
                for (int pf = 0; pf < 4; ++pf) { const int p = 16 * pf + fr; xf[pf] = *(const LAS bf16x8*)(lds + 65536 + p * 256 + (((4 * ks + fq) ^ (p & 15)) * 16)); }
                __builtin_amdgcn_sched_barrier(0);
#pragma unroll
                for (int pf = 0; pf < 4; ++pf) y1[pf] = __builtin_amdgcn_mfma_f32_16x16x32_bf16(xf[pf], mf, y1[pf], 0, 0, 0);
                __builtin_amdgcn_sched_barrier(0);
            }
        }
        {
            const float ea = __expf(acl[hh * 128 + l]), dsk = F.d_skip[h]; float ssq = 0.f;
            bf16* op = F.MIX + trow * DM + 1024 + h * 64;
#pragma unroll
            for (int pf = 0; pf < 4; ++pf) { const int p0 = 16 * pf + 4 * fq;
                const u32x2 xw = *(const LAS u32x2*)(lds + 81920 + l * 128 + p0 * 2);
                const float xv[4] = {bflo(xw.x), bfhi(xw.x), bflo(xw.y), bfhi(xw.y)}, zv[4] = {bflo(zw[pf].x), bfhi(zw[pf].x), bflo(zw[pf].y), bfhi(zw[pf].y)};
                float yo[4];
#pragma unroll
                for (int r = 0; r < 4; ++r) { const float y = (y1[pf][r] + ea * y2[pf][r] + dsk * xv[r]) * silu_f(zv[r]); ssq += y * y; yo[r] = y; }
                *(u32x2*)(op + p0) = (u32x2){cvtpk(yo[0], yo[1]), cvtpk(yo[2], yo[3])}; }
            ssq += __shfl_xor(ssq, 16); ssq += __shfl_xor(ssq, 32);
            if (fq == 0) F.SSQS[trow * 16 + h] = ssq;
        }
        if (hh < 7) { *(LAS u32x4*)(lds + 106496 + hp_p * 256 + ((hp_c ^ (hp_p & 15)) * 16)) = hq0; *(LAS u32x4*)(lds + 106496 + hp_p * 256 + (((hp_c + 1) ^ (hp_p & 15)) * 16)) = hq1; }
        __syncthreads();
    }
}
__device__ __forceinline__ void ph5(Frame& F) {
    for (int it = F.bid; it < 256; it += F.G) ssd_c_item(F, it >> 1, it & 1);
}

template <int NF, int N, bool I8>
__device__ __forceinline__ void skinny_group(f32x4 (&acc)[NF][2], const bf16* const (&bp)[NF], const bf16* ap, int K) {
    bf16x8 bfr[N][NF], af[N][2];
#pragma unroll
    for (int i = 0; i < N; ++i) {
#pragma unroll
        for (int b = 0; b < NF; ++b) bfr[i][b] = *(const bf16x8*)(bp[b] + i * 32);
#pragma unroll
        for (int mf = 0; mf < 2; ++mf) af[i][mf] = *(const bf16x8*)(ap + (size_t)mf * 16 * K + i * 32);
    }
    __builtin_amdgcn_sched_barrier(0);
#pragma unroll
    for (int i = 0; i < N; ++i)
#pragma unroll
        for (int mf = 0; mf < 2; ++mf)
#pragma unroll
            for (int b = 0; b < NF; ++b) {
                if constexpr (I8) acc[b][mf] = __builtin_bit_cast(f32x4, __builtin_amdgcn_mfma_i32_16x16x64_i8(__builtin_bit_cast(i32x4, bfr[i][b]), __builtin_bit_cast(i32x4, af[i][mf]), __builtin_bit_cast(i32x4, acc[b][mf]), 0, 0, 0));
                else acc[b][mf] = __builtin_amdgcn_mfma_f32_16x16x32_bf16(bfr[i][b], af[i][mf], acc[b][mf], 0, 0, 0);
            }
    __builtin_amdgcn_sched_barrier(0);
}
template <int MODE, bool I8 = false>
__device__ __forceinline__ void skinny_units(Frame& F, const bf16* A, const bf16* Bt, int K, int ngroups) {
    constexpr int NF = (MODE == 1 || MODE == 3) ? 4 : 2;
    const int lane = F.lane, w = F.wave, fr = lane & 15, fq = lane >> 4, kw = K >> 3, nks = kw >> 5;
    LAS f32x4* red = (LAS f32x4*)F.lds;
    for (int unit = F.bid; unit < 4 * ngroups; unit += F.G) {
        const int mg = unit & 3, ng = unit >> 2;
        f32x4 acc[NF][2];
#pragma unroll
        for (int b = 0; b < NF; ++b) { acc[b][0] = (f32x4){0.f, 0.f, 0.f, 0.f}; acc[b][1] = (f32x4){0.f, 0.f, 0.f, 0.f}; }
        const bf16* bp[NF];
#pragma unroll
        for (int b = 0; b < NF; ++b) {
            int brow;
            if (MODE == 3) brow = (ng >> 2) * 256 + (ng & 3) * 32 + (b >> 1) * 128 + (b & 1) * 16;
            else brow = ng * (NF * 16) + b * 16;
            bp[b] = Bt + (size_t)(brow + fr) * K + w * kw + 8 * fq;
        }
        const bf16* ap = A + (size_t)(mg * 32 + fr) * K + w * kw + 8 * fq;
        int ks = 0;
        if (NF == 2) {
#pragma unroll 1
            for (; ks + 8 <= nks; ks += 8) { const bf16* bq[NF];
#pragma unroll
                for (int b = 0; b < NF; ++b) bq[b] = bp[b] + ks * 32;
                skinny_group<NF, (NF == 2 ? 8 : 1), I8>(acc, bq, ap + ks * 32, K); }
        }
#pragma unroll 1
        for (; ks + 4 <= nks; ks += 4) { const bf16* bq[NF];
#pragma unroll
            for (int b = 0; b < NF; ++b) bq[b] = bp[b] + ks * 32;
            skinny_group<NF, 4, I8>(acc, bq, ap + ks * 32, K); }
#pragma unroll 1
        for (; ks < nks; ++ks) { const bf16* bq[NF];
#pragma unroll
            for (int b = 0; b < NF; ++b) bq[b] = bp[b] + ks * 32;
            skinny_group<NF, 1, I8>(acc, bq, ap + ks * 32, K); }
#pragma unroll
        for (int b = 0; b < NF; ++b)
#pragma unroll
            for (int mf = 0; mf < 2; ++mf) red[((w * NF + b) * 2 + mf) * 64 + lane] = acc[b][mf];
        __syncthreads();
        {
            const int b = w >> 1, mf = w & 1, m = mg * 32 + mf * 16 + fr; const size_t row = (size_t)LP + m;
            const bool active = (MODE == 3) ? (w < 4) : (w < 2 * NF);
            if (active) {
                f32x4 s0 = (f32x4){0.f, 0.f, 0.f, 0.f}, s1 = (f32x4){0.f, 0.f, 0.f, 0.f};
#pragma unroll
                for (int ww = 0; ww < 8; ++ww) {
                    if (MODE == 3) { s0 += red[((ww * NF + b) * 2 + mf) * 64 + lane]; s1 += red[((ww * NF + b + 2) * 2 + mf) * 64 + lane]; }
                    else if (MODE == 2) { if (ww < 4) s0 += red[((ww * NF + b) * 2 + mf) * 64 + lane]; else s1 += red[((ww * NF + b) * 2 + mf) * 64 + lane]; }
                    else s0 += red[((ww * NF + b) * 2 + mf) * 64 + lane];
                }
                if (MODE == 1) {
                    const int col = ng * 64 + b * 16 + 4 * fq;
                    *(f32x4*)(F.TAIL + (size_t)(128 + m) * NPROJ + col) = s0;
                } else if (MODE == 3) {
                    const int col = ng * 32 + b * 16 + 4 * fq;
                    float h[4];
                    if (I8) {
                        i32x4 g0 = (i32x4){0, 0, 0, 0}, u0 = (i32x4){0, 0, 0, 0};
#pragma unroll
                        for (int ww = 0; ww < 8; ++ww) { g0 += __builtin_bit_cast(i32x4, red[((ww * NF + b) * 2 + mf) * 64 + lane]); u0 += __builtin_bit_cast(i32x4, red[((ww * NF + b + 2) * 2 + mf) * 64 + lane]); }
                        const int wrow = (ng >> 2) * 256 + (ng & 3) * 32 + b * 16 + 4 * fq; const float sa = F.ASC[row];
                        const f32x4 sg = *(const f32x4*)(F.WSC + wrow), su = *(const f32x4*)(F.WSC + wrow + 128);
#pragma unroll
                        for (int r = 0; r < 4; ++r) { s0[r] = (float)g0[r] * (sa * sg[r]); s1[r] = (float)u0[r] * (sa * su[r]); }
                    }
#pragma unroll
                    for (int r = 0; r < 4; ++r) h[r] = silu_f(s0[r]) * s1[r];
                    *(u32x2*)(F.HB + row * DFF + col) = (u32x2){cvtpk(h[0], h[1]), cvtpk(h[2], h[3])};
                } else {
                    f32x4 v = s0;
                    if ((MODE == 4 || MODE == 2) && I8) {
                        i32x4 t0 = (i32x4){0, 0, 0, 0};
#pragma unroll
                        for (int ww = 0; ww < 8; ++ww) t0 += __builtin_bit_cast(i32x4, red[((ww * NF + b) * 2 + mf) * 64 + lane]);
                        const float sa = (MODE == 2 ? F.MSC : F.HSC)[row]; const f32x4 wsd = *(const f32x4*)((MODE == 2 ? F.WSC2 : F.WSCD) + ng * 32 + b * 16 + 4 * fq);
#pragma unroll
                        for (int r = 0; r < 4; ++r) v[r] = (float)t0[r] * (sa * wsd[r]);
                    }
                    if (MODE == 2 && !I8) {
                        const f32x4* pa = (const f32x4*)(F.SSQA + row * 16); const f32x4* ps = (const f32x4*)(F.SSQS + row * 16);
                        float sa = 0.f, ss = 0.f;
#pragma unroll
                        for (int i = 0; i < 4; ++i) { const f32x4 a = pa[i], c = ps[i]; sa += (a[0] + a[1]) + (a[2] + a[3]); ss += (c[0] + c[1]) + (c[2] + c[3]); }
                        const float ra = 1.0f / sqrtf(sa * (1.0f / 1024.0f) + EPS), rs = 1.0f / sqrtf(ss * (1.0f / 1024.0f) + EPS);
                        v = s0 * ra + s1 * rs;
                    }
                    const int col = ng * 32 + b * 16 + 4 * fq;
                    bf16* O = (MODE == 2) ? F.MIXOUT : F.FB; float* SQ = (MODE == 2) ? F.SSQ2S : F.SSQ4S;
                    *(u32x2*)(O + row * DM + col) = (u32x2){cvtpk(v[0], v[1]), cvtpk(v[2], v[3])};
                    float q = (v[0] * v[0] + v[1] * v[1]) + (v[2] * v[2] + v[3] * v[3]);
                    q += __shfl_xor(q, 16); q += __shfl_xor(q, 32);
                    if (fq == 0) SQ[m * 128 + ng * 2 + b] = q;
                }
            }
        }
        __syncthreads();
    }
}

struct P7In { f32x4 x[8]; u32x2 m[8]; float sq; };
__device__ __forceinline__ void p7_load(const Frame& F, int r, const float* xrow, P7In& in) {
    row_load8(xrow, F.lane, in.x);
    const u32x2* mo = (const u32x2*)(F.MIXOUT + (size_t)r * DM);
#pragma unroll
    for (int j = 0; j < 8; ++j) in.m[j] = __builtin_nontemporal_load(mo + F.lane + 64 * j);
    in.sq = (F.lane < 32) ? F.SSQ2[(size_t)r * 32 + F.lane] : 0.f;
}
template <bool LDSP>
__device__ __forceinline__ void p7_proc(const Frame& F, int r, P7In& in, const LAS f32x4* T, const f32x4* mod) {
    const int lane = F.lane;
    const float r1 = 1.0f / sqrtf(wave_sum(in.sq) * (1.0f / DM) + EPS);
    float ss = 0.f; u32x2* o1 = (u32x2*)(F.X1 + (size_t)r * DM);
#pragma unroll
    for (int j = 0; j < 8; ++j) {
        f32x4 cA; if (LDSP) cA = T[lane + 64 * j]; else cA = mod[lane + 64 * j] * ((const f32x4*)F.g_post_mix)[lane + 64 * j];
        const f32x4 mv = (f32x4){bflo(in.m[j].x), bfhi(in.m[j].x), bflo(in.m[j].y), bfhi(in.m[j].y)};
        const f32x4 v = in.x[j] + cA * (mv * r1); in.x[j] = v;
        ss += (v[0] * v[0] + v[1] * v[1]) + (v[2] * v[2] + v[3] * v[3]);
        o1[lane + 64 * j] = (u32x2){cvtpk(v[0], v[1]), cvtpk(v[2], v[3])};
    }
    const float r2 = 1.0f / sqrtf(wave_sum(ss) * (1.0f / DM) + EPS);
    float amax = 0.f;
#pragma unroll
    for (int j = 0; j < 8; ++j) {
        f32x4 cB, cC; if (LDSP) { cB = T[512 + lane + 64 * j]; cC = T[1024 + lane + 64 * j]; }
        else { cB = ((const f32x4*)F.g_pre_ffn)[lane + 64 * j] * (mod[2 * 512 + lane + 64 * j] + 1.0f); cC = mod[512 + lane + 64 * j]; }
        const f32x4 u = (in.x[j] * r2) * cB + cC; in.x[j] = u;
        amax = fmaxf(amax, fmaxf(fmaxf(fabsf(u[0]), fabsf(u[1])), fmaxf(fabsf(u[2]), fabsf(u[3]))));
    }
    amax = fmaxf(wave_max(amax), 1e-20f);
    const float qs = 127.0f / amax;
    if (lane == 0) F.ASC[r] = amax * (1.0f / 127.0f);
    unsigned* orow = (unsigned*)(F.U8 + (size_t)r * DM);
#pragma unroll
    for (int j = 0; j < 8; ++j) orow[lane + 64 * j] = pack_i8(in.x[j][0] * qs, in.x[j][1] * qs, in.x[j][2] * qs, in.x[j][3] * qs);
}
__device__ __forceinline__ void ph7(Frame& F) {
    LAS f32x4* T = (LAS f32x4*)F.lds;
    const int gw = F.bid * 8 + F.wave, NGW = F.G * 8, lane = F.lane;
    u32x4 wq[11];
    if (gw < DM) quant_load<11>(F.WdT + (size_t)gw * DFF, lane, wq);
    { const int i = F.tid; const f32x4* mod = (const f32x4*)(F.MODF + (size_t)128 * 8192);
      T[i] = mod[i] * ((const f32x4*)F.g_post_mix)[i]; T[512 + i] = ((const f32x4*)F.g_pre_ffn)[i] * (mod[2 * 512 + i] + 1.0f); T[1024 + i] = mod[512 + i]; }
    __syncthreads();
    if (gw < DM) quant_proc<11>(wq, F.Wd8 + (size_t)gw * DFF, F.WSCD + gw, lane);
    for (int n = gw + NGW; n < DM; n += NGW) quant_row<11>(F.WdT + (size_t)n * DFF, F.Wd8 + (size_t)n * DFF, F.WSCD + n, lane);
    {
        const bool spread = F.G >= 2 * NB;
        const int rs0 = spread ? ((F.wave == 0 && !(F.bid & 1)) ? LP + (F.bid >> 1) : MT) : LP + gw, rstep = spread ? MT : NGW;
        for (int r = rs0; r < MT; r += rstep) {
            P7In a; p7_load(F, r, F.xs + (size_t)(r - LP) * DM, a);
            a.sq = F.SSQ2S[(r - LP) * 128 + lane] + F.SSQ2S[(r - LP) * 128 + 64 + lane];
            p7_proc<false>(F, r, a, T, (const f32x4*)(F.MODF + (size_t)(r - LP) * 8192));
        }
    }
    {
        P7In a, b; int r = gw;
        if (r < LP) p7_load(F, r, F.xp + (size_t)r * DM, a);
#pragma unroll 1
        for (; r < LP; r += 2 * NGW) {
            const int r1 = r + NGW, r2 = r1 + NGW;
            if (r1 < LP) p7_load(F, r1, F.xp + (size_t)r1 * DM, b);
            p7_proc<true>(F, r, a, T, nullptr);
            if (r2 < LP) p7_load(F, r2, F.xp + (size_t)r2 * DM, a);
            if (r1 < LP) p7_proc<true>(F, r1, b, T, nullptr);
        }
    }
}
struct MqIn { u32x2 m[8]; float sq; };
__device__ __forceinline__ void mq_load(const Frame& F, int r, MqIn& in) {
    const int lane = F.lane;
    const u32x2* mr = (const u32x2*)(F.MIX + (size_t)r * DM);
#pragma unroll
    for (int j = 0; j < 8; ++j) in.m[j] = __builtin_nontemporal_load(mr + lane + 64 * j);
    in.sq = (lane < 16) ? F.SSQA[(size_t)r * 16 + lane] : (lane < 32) ? F.SSQS[(size_t)r * 16 + lane - 16] : 0.f;
}
__device__ __forceinline__ void mq_proc(const Frame& F, int r, const MqIn& in, const f32x4 (&gn)[8]) {
    const int lane = F.lane;
    float sq = in.sq;
    sq += __shfl_xor(sq, 1); sq += __shfl_xor(sq, 2); sq += __shfl_xor(sq, 4); sq += __shfl_xor(sq, 8);
    const float ra = 1.0f / sqrtf(__shfl(sq, 0) * (1.0f / 1024.0f) + EPS), rs = 1.0f / sqrtf(__shfl(sq, 16) * (1.0f / 1024.0f) + EPS);
    f32x4 v[8]; float amax = 0.f;
#pragma unroll
    for (int j = 0; j < 8; ++j) { const float f = (j < 4) ? ra : rs; v[j] = (f32x4){bflo(in.m[j].x) * f, bfhi(in.m[j].x) * f, bflo(in.m[j].y) * f, bfhi(in.m[j].y) * f} * gn[j];
        amax = fmaxf(amax, fmaxf(fmaxf(fabsf(v[j][0]), fabsf(v[j][1])), fmaxf(fabsf(v[j][2]), fabsf(v[j][3])))); }
    amax = fmaxf(wave_max(amax), 1e-30f);
    const float qs = 127.0f / amax;
    if (lane == 0) F.MSC[r] = amax * (1.0f / 127.0f);
    unsigned* o8 = (unsigned*)(F.MIX8 + (size_t)r * DM);
#pragma unroll
    for (int j = 0; j < 8; ++j) o8[lane + 64 * j] = pack_i8(v[j][0] * qs, v[j][1] * qs, v[j][2] * qs, v[j][3] * qs);
}
__device__ __forceinline__ void ph_mq(Frame& F) {
    const int gw = F.bid * 8 + F.wave, NGW = F.G * 8;
    const bool spread = F.G >= 2 * NB; const int NR = spread ? LP : MT;
    const int rs = (spread && F.wave == 0 && !(F.bid & 1) && (F.bid >> 1) < NB) ? LP + (F.bid >> 1) : -1;
    f32x4 gn[8];
#pragma unroll
    for (int j = 0; j < 8; ++j) gn[j] = (j < 4) ? ((const f32x4*)F.g_att)[F.lane + 64 * j] : ((const f32x4*)F.g_ssm)[F.lane + 64 * (j - 4)];
    MqIn a, b, c; int r = gw;
    if (rs >= 0) mq_load(F, rs, c);
    if (r < NR) mq_load(F, r, a);
    if (rs >= 0) mq_proc(F, rs, c, gn);
#pragma unroll 1
    for (; r < NR; r += 2 * NGW) {
        const int r1 = r + NGW, r2 = r1 + NGW;
        if (r1 < NR) mq_load(F, r1, b);
        mq_proc(F, r, a, gn);
        if (r2 < NR) mq_load(F, r2, a);
        if (r1 < NR) mq_proc(F, r1, b, gn);
    }
}
__device__ __forceinline__ void ph_hq(Frame& F) {
    const int gw = F.bid * 8 + F.wave, NGW = F.G * 8;
    const bool spread = F.G >= 2 * NB; const int NR = spread ? LP : MT;
    if (spread && F.wave == 0 && !(F.bid & 1) && (F.bid >> 1) < NB) { const int r = LP + (F.bid >> 1); quant_row<11>(F.HB + (size_t)r * DFF, F.H8 + (size_t)r * DFF, F.HSC + r, F.lane); }
#pragma unroll 1
    for (int r = gw; r < NR; r += NGW) quant_row<11>(F.HB + (size_t)r * DFF, F.H8 + (size_t)r * DFF, F.HSC + r, F.lane);
}
struct P10In { u32x2 x[8]; u32x2 f[8]; float sq; };
__device__ __forceinline__ void p10_load(const Frame& F, int r, P10In& in) {
    const u32x2* xo = (const u32x2*)(F.X1 + (size_t)r * DM); const u32x2* fo = (const u32x2*)(F.FB + (size_t)r * DM);
#pragma unroll
    for (int j = 0; j < 8; ++j) { in.x[j] = __builtin_nontemporal_load(xo + F.lane + 64 * j); in.f[j] = __builtin_nontemporal_load(fo + F.lane + 64 * j); }
    in.sq = (F.lane < 32) ? F.SSQ4[(size_t)r * 32 + F.lane] : 0.f;
}
template <bool SAMPLE>
__device__ __forceinline__ void p10_proc(const Frame& F, int r, P10In& in, const f32x4 (&cA)[8]) {
    const float r4 = 1.0f / sqrtf(wave_sum(in.sq) * (1.0f / DM) + EPS);
    f32x4* yr = (f32x4*)(F.out + O_Y + (size_t)r * DM);
#pragma unroll
    for (int j = 0; j < 8; ++j) {
        const f32x4 fv = (f32x4){bflo(in.f[j].x), bfhi(in.f[j].x), bflo(in.f[j].y), bfhi(in.f[j].y)};
        const f32x4 xv = (f32x4){bflo(in.x[j].x), bfhi(in.x[j].x), bflo(in.x[j].y), bfhi(in.x[j].y)};
        f32x4 c; if (SAMPLE) c = ((const f32x4*)(F.MODF + (size_t)(r - LP) * 8192))[3 * 512 + F.lane + 64 * j] * ((const f32x4*)F.g_post_ffn)[F.lane + 64 * j]; else c = cA[j];
        __builtin_nontemporal_store(xv + c * (fv * r4), yr + F.lane + 64 * j);
    }
}
__device__ __forceinline__ void ph10(Frame& F) {
    const int gw = F.bid * 8 + F.wave, NGW = F.G * 8, lane = F.lane;
    f32x4 cA[8];
#pragma unroll
    for (int j = 0; j < 8; ++j) cA[j] = ((const f32x4*)(F.MODF + (size_t)128 * 8192))[3 * 512 + lane + 64 * j] * ((const f32x4*)F.g_post_ffn)[lane + 64 * j];
    {
        const bool spread = F.G >= 2 * NB;
        const int rs0 = spread ? ((F.wave == 0 && !(F.bid & 1)) ? LP + (F.bid >> 1) : MT) : LP + gw, rstep = spread ? MT : NGW;
        for (int r = rs0; r < MT; r += rstep) {
            P10In a; p10_load(F, r, a); a.sq = F.SSQ4S[(r - LP) * 128 + lane] + F.SSQ4S[(r - LP) * 128 + 64 + lane]; p10_proc<true>(F, r, a, cA);
        }
    }
    {
        P10In a, b; int r = gw;
        if (r < LP) p10_load(F, r, a);
#pragma unroll 1
        for (; r < LP; r += 2 * NGW) {
            const int r1 = r + NGW, r2 = r1 + NGW;
            if (r1 < LP) p10_load(F, r1, b);
            p10_proc<false>(F, r, a, cA);
            if (r2 < LP) p10_load(F, r2, a);
            if (r1 < LP) p10_proc<false>(F, r1, b, cA);
        }
    }
}

constexpr int N_PHASES = 13;
struct Args { const float* in[27]; float* out; unsigned char* ws; int ph_lo, ph_hi; };
__global__ void __launch_bounds__(512, 2) mk_fwd(Args args) {
    extern __shared__ __attribute__((aligned(16))) unsigned char lds_raw[];
    Frame F;
    F.lds = (LAS unsigned char*)lds_raw;
    F.tid = threadIdx.x; F.lane = F.tid & 63; F.wave = __builtin_amdgcn_readfirstlane(F.tid >> 6);
    F.G = gridDim.x; F.bid = blockIdx.x;
    unsigned char* ws = args.ws;
    F.xp = args.in[0]; F.xs = args.in[1]; F.cache_k = args.in[2]; F.cache_v = args.in[3]; F.state_conv = args.in[4]; F.state_ssm = args.in[5]; F.c_prompt = args.in[6]; F.c_sample = args.in[7];
    F.w_ada = args.in[8]; F.b_ada = args.in[9]; F.g_pre_mix = args.in[10]; F.g_post_mix = args.in[11]; F.w_in = args.in[12]; F.sinks = args.in[13]; F.g_att = args.in[14];
    F.conv_w = args.in[15]; F.conv_b = args.in[16]; F.dt_bias = args.in[17]; F.a_log = args.in[18]; F.d_skip = args.in[19]; F.g_ssm = args.in[20]; F.w_out = args.in[21];
    F.g_pre_ffn = args.in[22]; F.g_post_ffn = args.in[23]; F.w_gate = args.in[24]; F.w_up = args.in[25]; F.w_down = args.in[26];
    F.out = args.out;
    F.X1 = (bf16*)(ws + WS_X1); F.U8 = (signed char*)(ws + WS_U8); F.Wgu8 = (signed char*)(ws + WS_WGU8); F.ASC = (float*)(ws + WS_ASC); F.WSC = (float*)(ws + WS_WSC); F.H8 = (signed char*)(ws + WS_H8); F.Wd8 = (signed char*)(ws + WS_WD8); F.HSC = (float*)(ws + WS_HSC); F.WSCD = (float*)(ws + WS_WSCD); F.Win8 = (signed char*)(ws + WS_WIN8); F.U18 = (signed char*)(ws + WS_U18); F.ASC1 = (float*)(ws + WS_ASC1); F.WSC1 = (float*)(ws + WS_WSC1); F.MIX8 = (signed char*)(ws + WS_MIX8); F.Wout8 = (signed char*)(ws + WS_WOUT8); F.MSC = (float*)(ws + WS_MSC); F.WSC2 = (float*)(ws + WS_WSC2); F.WinT = (bf16*)(ws + WS_WIN); F.WoutT = (bf16*)(ws + WS_WOUT); F.WguT = (bf16*)(ws + WS_WGU); F.WdT = (bf16*)(ws + WS_WD);
    F.U = (bf16*)(ws + WS_U); F.PROJ = (bf16*)(ws + WS_PROJ); F.MIX = (bf16*)(ws + WS_MIX); F.MIXOUT = (bf16*)(ws + WS_MIXOUT); F.HB = (bf16*)(ws + WS_H); F.FB = (bf16*)(ws + WS_F);
    F.HPREV = (bf16*)(ws + WS_HPREV);
    F.MODP = (float*)(ws + WS_MODP); F.MODF = (float*)(ws + WS_MODF); F.DT = (float*)(ws + WS_DT); F.SSQA = (float*)(ws + WS_SSQA); F.SSQS = (float*)(ws + WS_SSQS); F.SSQ2 = (float*)(ws + WS_SSQ2); F.SSQ4 = (float*)(ws + WS_SSQ4); F.SSQ2S = (float*)(ws + WS_SSQ2S); F.SSQ4S = (float*)(ws + WS_SSQ4S);
    F.TAIL = (float*)(ws + WS_TAIL); F.STATES = (bf16*)(ws + WS_STATES); F.DECAY = (float*)(ws + WS_DECAY); F.WDT = (float*)(ws + WS_WDT);

    for (int u = F.tid; u < (LDS_BYTES - LDSCTL_OFF) / 4; u += 512) ((LAS unsigned*)(F.lds + LDSCTL_OFF))[u] = 0u;
    __syncthreads();
    XcdBarrier bar; bar.bar = (unsigned*)(ws + WS_CTL) + CW_BAR; bar.x = 0; bar.st = nullptr;
    if (MK_N_LAUNCHES == 1) bar = xcd_barrier_post((unsigned*)(ws + WS_CTL) + CW_BAR, (volatile LAS unsigned*)(F.lds + MISC_OFF) + 8);
    const int lo = args.ph_lo, hi = args.ph_hi;
#define IN(k) (lo <= (k) && (k) < hi)
#define SEAM(k) do { if (IN(k) && IN((k) + 1)) xcd_barrier(bar); } while (0)

#define RUN_G1() do { if (F.bid & 1) prep_late(F); { pg8::Gemm g{(const bf16*)F.U18, (const bf16*)F.Win8, LP, 4096, DM / 2, 0ull}; pg8::StaticOrder S; S.init(LP, 4096, F.G, F.bid, 2); pg8::EpiProj<true> E{F.PROJ, NPROJ, F.TAIL, F.ASC1, F.WSC1}; pg8::gemm_phase<pg8::EpiProj<true>, true, true>(F.lds, g, S, E); }   \
        for (int rep_ = 0; rep_ < 1 + ((PROBE_SUB >> (7 + 1)) & 1); ++rep_) skinny_units<1>(F, F.U + (size_t)LP * DM, F.WinT, DM, NPROJ / 64); if (!(F.bid & 1)) prep_late(F); } while (0)
#define RUN_G2() do { if (F.bid & 1) { for (int rep_ = 0; rep_ < 1 + ((PROBE_SUB >> (7 + 2)) & 1); ++rep_) skinny_units<2, true>(F, (const bf16*)(F.MIX8 + (size_t)LP * DM), (const bf16*)F.Wout8, DM / 2, DM / 32); } { pg8::Gemm g{(const bf16*)F.MIX8, (const bf16*)F.Wout8, LP, DM, DM / 2, 0ull}; pg8::StaticOrder S; S.init(LP, DM, F.G, F.bid, 4); pg8::EpiRowSsq<false, true> E{F.MIXOUT, DM, F.SSQ2, nullptr, nullptr, F.MSC, F.WSC2}; pg8::gemm_phase<pg8::EpiRowSsq<false, true>, true, true>(F.lds, g, S, E); } \
        if (!(F.bid & 1)) { for (int rep_ = 0; rep_ < 1 + ((PROBE_SUB >> (7 + 2)) & 1); ++rep_) skinny_units<2, true>(F, (const bf16*)(F.MIX8 + (size_t)LP * DM), (const bf16*)F.Wout8, DM / 2, DM / 32); } } while (0)
#define RUN_G3() do { if (F.bid & 1) { for (int rep_ = 0; rep_ < 1 + ((PROBE_SUB >> (7 + 3)) & 1); ++rep_) skinny_units<3, true>(F, (const bf16*)(F.U8 + (size_t)LP * DM), (const bf16*)F.Wgu8, DM / 2, DFF / 32); } { pg8::Gemm g{(const bf16*)F.U8, (const bf16*)F.Wgu8, LP, 2 * DFF, DM / 2, 0ull}; pg8::StaticOrder S; S.init(LP, 2 * DFF, F.G, F.bid); pg8::EpiSwiGLU E{F.HB, DFF, F.ASC, F.WSC}; pg8::gemm_phase<pg8::EpiSwiGLU, true, true>(F.lds, g, S, E); } \
        if (!(F.bid & 1)) { for (int rep_ = 0; rep_ < 1 + ((PROBE_SUB >> (7 + 3)) & 1); ++rep_) skinny_units<3, true>(F, (const bf16*)(F.U8 + (size_t)LP * DM), (const bf16*)F.Wgu8, DM / 2, DFF / 32); } } while (0)
#define RUN_G4() do { if (F.bid & 1) { for (int rep_ = 0; rep_ < 1 + ((PROBE_SUB >> (7 + 4)) & 1); ++rep_) skinny_units<4, true>(F, (const bf16*)(F.H8 + (size_t)LP * DFF), (const bf16*)F.Wd8, DFF / 2, DM / 32); } { pg8::Gemm g{(const bf16*)F.H8, (const bf16*)F.Wd8, LP, DM, DFF / 2, 0ull}; pg8::StaticOrder S; S.init(LP, DM, F.G, F.bid, 4); pg8::EpiRowSsq<false, true> E{F.FB, DM, F.SSQ4, nullptr, nullptr, F.HSC, F.WSCD}; pg8::gemm_phase<pg8::EpiRowSsq<false, true>, true, true>(F.lds, g, S, E); } \
        if (!(F.bid & 1)) { for (int rep_ = 0; rep_ < 1 + ((PROBE_SUB >> (7 + 4)) & 1); ++rep_) skinny_units<4, true>(F, (const bf16*)(F.H8 + (size_t)LP * DFF), (const bf16*)F.Wd8, DFF / 2, DM / 32); } } while (0)
#define PHASE(k, BODY) do { if (IN(k)) { BODY; if (PROBE_MASK & (1u << (k))) { xcd_barrier(bar); BODY; } } SEAM(k); if ((PROBE_SUB >> 7) & 1) SEAM(k); } while (0)
    PHASE(0, ph0(F));
    PHASE(1, ph1(F));
    PHASE(2, RUN_G1());
    PHASE(3, ph3(F));
    PHASE(4, ph4(F));
    PHASE(5, ph5(F));
    PHASE(6, ph_mq(F));
    PHASE(7, RUN_G2());
    PHASE(8, ph7(F));
    PHASE(9, RUN_G3());
    PHASE(10, ph_hq(F));
    PHASE(11, RUN_G4());
    PHASE(12, ph10(F));
#undef IN
#undef SEAM
}

extern "C" void kernel_launch(void* const* d_in, const int* in_sizes, int n_in, void* d_out, int out_size, void* d_ws, size_t ws_size, hipStream_t stream) {
    static int grid = 0;
    if (grid == 0) {
        if (n_in != 27 || ws_size < WS_END) { fprintf(stderr, "kernel_launch: unexpected n_in %d / ws %zu\n", n_in, ws_size); grid = -1; return; }
        int dev = 0, cus = 0;
        if (hipGetDevice(&dev) != hipSuccess || hipDeviceGetAttribute(&cus, hipDeviceAttributeMultiprocessorCount, dev) != hipSuccess) { grid = -1; return; }
        if (hipFuncSetAttribute((const void*)mk_fwd, hipFuncAttributeMaxDynamicSharedMemorySize, LDS_BYTES) != hipSuccess) { fprintf(stderr, "kernel_launch: hipFuncSetAttribute failed\n"); grid = -1; return; }
        int per_cu = 0;
        (void)hipOccupancyMaxActiveBlocksPerMultiprocessor(&per_cu, (const void*)mk_fwd, 512, LDS_BYTES);
        (void)hipGetLastError();
        if (per_cu < 1) fprintf(stderr, "kernel_launch: occupancy query reports %d blocks per CU\n", per_cu);
        grid = cus;
    }
    if (grid < 0) return;
    (void)hipMemsetAsync((char*)d_ws + WS_CTL + (size_t)CW_BAR * 4, 0, 16384, stream);
    Args a{};
    for (int i = 0; i < 27; ++i) a.in[i] = (const float*)d_in[i];
    a.out = (float*)d_out; a.ws = (unsigned char*)d_ws;
    if (MK_N_LAUNCHES == 1) {
        a.ph_lo = 0; a.ph_hi = N_PHASES;
        hipLaunchKernelGGL(mk_fwd, dim3(grid), dim3(512), LDS_BYTES, stream, a);
    } else {
        for (int p = 0; p < N_PHASES; ++p) { a.ph_lo = p; a.ph_hi = p + 1; hipLaunchKernelGGL(mk_fwd, dim3(grid), dim3(512), LDS_BYTES, stream, a); }
    }
}
```
